# Optimizing an MI355X kernel written in HIP

```python
import jax, jax.numpy as jnp
from jax import lax
import numpy as np

D_MODEL = 2048
BATCH = 4
SEQ = 2048
DEPTH = 2
DEC_BATCH = 32
DEC_SEQ = 16
PAST_LEN = 1024

CHUNK = 64
Q_BLOCK = 128
HEAD_DIM = 128
FOX_HEADS = 8
SB_HEADS = 8
FOX_WIDTH = FOX_HEADS * HEAD_DIM
SB_WIDTH = SB_HEADS * HEAD_DIM
N_AB = 4 * FOX_WIDTH + 4 * SB_WIDTH + FOX_HEADS
MLP_EXPAND = 2
C_WIDTH = MLP_EXPAND * D_MODEL
C_GROUPS = 16
C_GROUP_DIM = C_WIDTH // C_GROUPS
C_CHUNK = 128
RMS_EPS = 1e-6
LN_EPS = 1e-5
FORGET_BIAS = 2.0
ATTN_SCALE = HEAD_DIM ** -0.5

kernel_name = 'hybrid_fox_stickbreak_gmlp_stream_step'


def rmsnorm(x, g):
    x32 = x.astype(jnp.float32)
    y = x32 * lax.rsqrt(jnp.mean(x32 * x32, axis=-1, keepdims=True) + RMS_EPS)
    return (y * g.astype(jnp.float32)).astype(x.dtype)


def layernorm(x, g, b):
    x32 = x.astype(jnp.float32)
    mu = jnp.mean(x32, axis=-1, keepdims=True)
    xc = x32 - mu
    y = xc * lax.rsqrt(jnp.mean(xc * xc, axis=-1, keepdims=True) + LN_EPS)
    return (y * g.astype(jnp.float32) + b.astype(jnp.float32)).astype(x.dtype)


def _heads(t, n):
    return t.reshape(t.shape[0], t.shape[1], n, HEAD_DIM)


def ab_project(h, w_in0, b_forget):
    p = jnp.einsum('bsd,dn->bsn', h, w_in0)
    o = 0
    parts = []
    for width in (FOX_WIDTH,) * 4 + (SB_WIDTH,) * 4:
        parts.append(p[..., o:o + width])
        o += width
    f_logit = p[..., o:o + FOX_HEADS].astype(jnp.float32) + b_forget.astype(jnp.float32)
    logf = jax.nn.log_sigmoid(f_logit)
    fq, fk, fv = (_heads(t, FOX_HEADS) for t in parts[0:3])
    sq, sk, sv = (_heads(t, SB_HEADS) for t in parts[4:7])
    return fq, fk, fv, parts[3], logf, sq, sk, sv, parts[7]


def fox_core(q, k, v, Fq, Fk, qpos, kpos):
    s = jnp.einsum('bqhd,bkhd->bhqk', q, k).astype(jnp.float32) * ATTN_SCALE
    s = s + (jnp.swapaxes(Fq, 1, 2)[..., :, None] - jnp.swapaxes(Fk, 1, 2)[..., None, :])
    causal = kpos[None, :] <= qpos[:, None]
    s = jnp.where(causal, s, -jnp.inf)
    p = jax.nn.softmax(s, axis=-1)
    return jnp.einsum('bhqk,bkhd->bqhd', p.astype(v.dtype), v)


def sb_core(q, k, v, qpos, kpos):
    z = jnp.einsum('bqhd,bkhd->bhqk', q, k).astype(jnp.float32) * ATTN_SCALE
    before = kpos[None, :] < qpos[:, None]
    log_stay = jnp.where(before, jax.nn.log_sigmoid(-z), 0.0)
    after = lax.cumsum(log_stay, axis=3, reverse=True) - log_stay
    a = jnp.where(before, jnp.exp(jax.nn.log_sigmoid(z) + after), 0.0)
    return jnp.einsum('bhqk,bkhd->bqhd', a.astype(v.dtype), v)


def fox_prompt(q, k, v, logf):
    B_, S_, H, Dh = q.shape
    nb = S_ // Q_BLOCK
    F = jnp.cumsum(logf, axis=1)
    kpos = jnp.arange(S_)
    qb = q.reshape(B_, nb, Q_BLOCK, H, Dh).swapaxes(0, 1)
    Fb = F.reshape(B_, nb, Q_BLOCK, H).swapaxes(0, 1)

    def block(args):
        i, qi, Fi = args
        return fox_core(qi, k, v, Fi, F, i * Q_BLOCK + jnp.arange(Q_BLOCK), kpos)

    o = lax.map(block, (jnp.arange(nb), qb, Fb))
    return o.swapaxes(0, 1).reshape(B_, S_, H * Dh)


def sb_prompt(q, k, v):
    B_, S_, H, Dh = q.shape
    nb = S_ // Q_BLOCK
    kpos = jnp.arange(S_)
    qb = q.reshape(B_, nb, Q_BLOCK, H, Dh).swapaxes(0, 1)

    def block(args):
        i, qi = args
        return sb_core(qi, k, v, i * Q_BLOCK + jnp.arange(Q_BLOCK), kpos)

    o = lax.map(block, (jnp.arange(nb), qb))
    return o.swapaxes(0, 1).reshape(B_, S_, H * Dh)


def c_project(h, w_in1, ln_g, ln_b):
    p = jnp.einsum('bsd,dn->bsn', h, w_in1)
    u = p[..., :C_WIDTH]
    v = layernorm(p[..., C_WIDTH:2 * C_WIDTH], ln_g, ln_b)
    z = p[..., 2 * C_WIDTH:]
    return u, v, z


def spatial_mix(v, w_sp, b_sp):
    B_, N, L, _ = v.shape
    vg = v.reshape(B_, N, L, C_GROUPS, C_GROUP_DIM)
    causal = jnp.tril(jnp.ones((L, L), dtype=bool))
    w = jnp.where(causal, w_sp[:, :L, :L], 0.0).astype(v.dtype)
    mixed = jnp.einsum('gts,bnsgc->bntgc', w, vg) + b_sp[:, :L].T[None, None, :, :, None].astype(v.dtype)
    return mixed.reshape(B_, N, L, C_WIDTH)


def setup_inputs(seed: int = 0) -> dict:
    key = jax.random.key(seed)
    ks = jax.random.split(key, 20)
    nrm = lambda k, shape, scale: jax.random.normal(k, shape, jnp.float32) * scale
    kv_shape = (DEC_BATCH, PAST_LEN, FOX_HEADS, HEAD_DIM)
    sb_shape = (DEC_BATCH, PAST_LEN, SB_HEADS, HEAD_DIM)
    return {
        'x_prompt': nrm(ks[0], (BATCH, SEQ, D_MODEL), 1.0),
        'x_sample': nrm(ks[1], (DEC_BATCH, DEC_SEQ, D_MODEL), 1.0),
        'cache_fox_k': nrm(ks[2], kv_shape, 1.0),
        'cache_fox_v': nrm(ks[3], kv_shape, 1.0),
        'cache_fox_logf': jax.nn.log_sigmoid(FORGET_BIAS + nrm(ks[4], (DEC_BATCH, PAST_LEN, FOX_HEADS), 1.0)),
        'cache_sb_k': nrm(ks[5], sb_shape, 1.0),
        'cache_sb_v': nrm(ks[6], sb_shape, 1.0),
        'norm0_g': 1.0 + nrm(ks[7], (D_MODEL,), 0.02),
        'w_in0': nrm(ks[8], (D_MODEL, N_AB), D_MODEL ** -0.5),
        'b_forget': FORGET_BIAS + nrm(ks[9], (FOX_HEADS,), 0.1),
        'w_out0': nrm(ks[10], (FOX_WIDTH + SB_WIDTH, D_MODEL), (FOX_WIDTH + SB_WIDTH) ** -0.5),
        'norm1_g': 1.0 + nrm(ks[11], (D_MODEL,), 0.02),
        'w_in1': nrm(ks[12], (D_MODEL, 3 * C_WIDTH), D_MODEL ** -0.5),
        'sgu_ln_g': 1.0 + nrm(ks[13], (C_WIDTH,), 0.02),
        'sgu_ln_b': nrm(ks[14], (C_WIDTH,), 0.02),
        'w_sp': nrm(ks[15], (C_GROUPS, C_CHUNK, C_CHUNK), C_CHUNK ** -0.5),
        'b_sp': 1.0 + nrm(ks[16], (C_GROUPS, C_CHUNK), 0.1),
        'w_out1': nrm(ks[17], (C_WIDTH, D_MODEL), C_WIDTH ** -0.5),
        'final_g': 1.0 + nrm(ks[18], (D_MODEL,), 0.02),
    }


def reference(x_prompt, x_sample, cache_fox_k, cache_fox_v, cache_fox_logf, cache_sb_k, cache_sb_v,
              norm0_g, w_in0, b_forget, w_out0, norm1_g, w_in1, sgu_ln_g, sgu_ln_b, w_sp, b_sp, w_out1, final_g):
    hp = x_prompt
    hs = x_sample
    S_ = x_prompt.shape[1]
    P = cache_fox_k.shape[1]
    T = x_sample.shape[1]
    for layer in range(DEPTH):
        if layer % 2 == 0:
            fq, fk, fv, fz, logf_p, sq, sk, sv, sz = ab_project(rmsnorm(hp, norm0_g), w_in0, b_forget)
            fo = fox_prompt(fq, fk, fv, logf_p)
            so = sb_prompt(sq, sk, sv)
            mix = jnp.concatenate([fo * jax.nn.silu(fz), so * jax.nn.silu(sz)], axis=-1)
            hp = hp + jnp.einsum('bsn,nd->bsd', mix, w_out0)
            fox_k_prompt, fox_v_prompt, fox_logf_prompt = fk, fv, logf_p
            sb_k_prompt, sb_v_prompt = sk, sv
            gq, gk, gv, gz, logf_s, tq, tk, tv, tz = ab_project(rmsnorm(hs, norm0_g), w_in0, b_forget)
            qpos = P + jnp.arange(T)
            kpos = jnp.arange(P + T)
            k_all = jnp.concatenate([cache_fox_k.astype(gk.dtype), gk], axis=1)
            v_all = jnp.concatenate([cache_fox_v.astype(gv.dtype), gv], axis=1)
            F_all = jnp.cumsum(jnp.concatenate([cache_fox_logf.astype(jnp.float32), logf_s], axis=1), axis=1)
            go = fox_core(gq, k_all, v_all, F_all[:, P:], F_all, qpos, kpos).reshape(T and hs.shape[0], T, FOX_WIDTH)
            sk_all = jnp.concatenate([cache_sb_k.astype(tk.dtype), tk], axis=1)
            sv_all = jnp.concatenate([cache_sb_v.astype(tv.dtype), tv], axis=1)
            to = sb_core(tq, sk_all, sv_all, qpos, kpos).reshape(hs.shape[0], T, SB_WIDTH)
            mix_s = jnp.concatenate([go * jax.nn.silu(gz), to * jax.nn.silu(tz)], axis=-1)
            hs = hs + jnp.einsum('bsn,nd->bsd', mix_s, w_out0)
            fox_k_sample, fox_v_sample, fox_logf_sample = gk, gv, logf_s
            sb_k_sample, sb_v_sample = tk, tv
        else:
            u, v, z = c_project(rmsnorm(hp, norm1_g), w_in1, sgu_ln_g, sgu_ln_b)
            Bp = hp.shape[0]
            mixed = spatial_mix(v.reshape(Bp, S_ // C_CHUNK, C_CHUNK, C_WIDTH), w_sp, b_sp).reshape(Bp, S_, C_WIDTH)
            hp = hp + jnp.einsum('bsn,nd->bsd', u * mixed * jax.nn.silu(z), w_out1)
            us, vs, zs = c_project(rmsnorm(hs, norm1_g), w_in1, sgu_ln_g, sgu_ln_b)
            mixed_s = spatial_mix(vs[:, None], w_sp, b_sp)[:, 0]
            hs = hs + jnp.einsum('bsn,nd->bsd', us * mixed_s * jax.nn.silu(zs), w_out1)
            sgu_v_sample = vs
    y_prompt = rmsnorm(hp, final_g)
    y_sample = rmsnorm(hs, final_g)
    return (y_prompt, y_sample,
            fox_k_prompt, fox_v_prompt, fox_logf_prompt,
            fox_k_sample, fox_v_sample, fox_logf_sample,
            sb_k_prompt, sb_v_prompt,
            sb_k_sample, sb_v_sample,
            sgu_v_sample)
```

```cpp
#include <hip/hip_runtime.h>
#include <hip/hip_cooperative_groups.h>
#include <cstdio>
#include <cstdint>
namespace cg = cooperative_groups;

#ifndef MK_N_LAUNCHES
#define MK_N_LAUNCHES 1
#endif
namespace pg8 {
#define PG8_LAS __attribute__((address_space(3)))
typedef unsigned short bf16_t;
typedef short bf16x8 __attribute__((ext_vector_type(8)));
typedef float f32x4 __attribute__((ext_vector_type(4)));
typedef unsigned u32x4 __attribute__((ext_vector_type(4)));
constexpr int BM = 256, BK = 64, HALF = 128, HTB = HALF * BK * 2  , STAGE_BYTES = 8 * HTB, NXCD = 8, WGM = 8;

__host__ __device__ __forceinline__ int lds_byte(int r, int c) { const int st = (r >> 4) * 2 + (c >> 5), rr = r & 15, cc = c & 31, ob = rr * 64 + cc * 2; return st * 1024 + (ob ^ (((ob >> 9) & 1) << 5)); }
__host__ __device__ __forceinline__ void stage_rc(int b, int& R, int& C) { const int st = b / 1024, sb = b % 1024, swz = sb ^ (((sb >> 9) & 1) << 5); R = (st >> 1) * 16 + swz / 64; C = (st & 1) * 32 + (swz % 64) / 2; }
__host__ __device__ __forceinline__ int perm32(int rho) { const int n = rho >> 4, i = rho & 15; return 8 * (i >> 2) + 4 * n + (i & 3); }

struct Unit { int pm, pn; };
struct Gemm { const bf16_t* A; const bf16_t* Bt; int M, N, K; };

struct StaticOrder {
    int nM, nN, nwg, G, c;
    __host__ __device__ void init(int M, int N, int G_, int c_) { nM = M / BM; nN = N / BM; nwg = nM * nN; G = G_; c = c_; }
    __host__ __device__ bool next(int i, Unit& u) const {
        const long L = (long)i * G + c; if (L >= nwg) return false;
        int wgid = (int)L; { const int q = nwg / NXCD, r = nwg % NXCD, xcd = wgid % NXCD, off = wgid / NXCD; wgid = (xcd < r ? xcd * (q + 1) : r * (q + 1) + (xcd - r) * q) + off; }
        const int nig = WGM * nN, gid = wgid / nig, fm = gid * WGM, gsz = (nM - fm) < WGM ? (nM - fm) : WGM;
        u.pm = fm + ((wgid % nig) % gsz); u.pn = (wgid % nig) / gsz; return true;
    }
    __device__ __forceinline__ void a_ready(const Unit&) const {}
    __device__ __forceinline__ void done(const Unit&) const {}
};

__device__ __forceinline__ unsigned cvt_pk_bf16(float lo, float hi) { unsigned r; asm volatile("v_cvt_pk_bf16_f32 %0, %1, %2" : "=v"(r) : "v"(lo), "v"(hi)); return r; }
typedef float f32x2 __attribute__((ext_vector_type(2)));
template <class Epi, class Sched, bool ALIGN_EPI = false, bool SP2 = false>
__device__ __forceinline__ void gemm_phase(PG8_LAS unsigned char* lds, const Gemm g, const Sched& S, const Epi& E) {
    const int tid = threadIdx.x, wid = __builtin_amdgcn_readfirstlane(tid >> 6), lane = tid & 63, wr = wid >> 2, wc = wid & 3, fr = lane & 15, fq = lane >> 4;
    const int K = g.K, nt = K / BK;
    unsigned voffA[2], voffB[2];
#pragma unroll
    for (int i = 0; i < 2; ++i) { int R, C; stage_rc(tid * 16 + i * 8192, R, C); const int Rb = Epi::PERM ? ((R & ~31) + perm32(R & 31)) : R;
        voffA[i] = (unsigned)(R * K + C) * 2u; voffB[i] = (unsigned)(Rb * K + C) * 2u; }
    const size_t kstep = (size_t)(BK * 2);
    const size_t hstep = (size_t)HALF * K * 2;
    const size_t tstep = 2 * hstep;
    const unsigned ldsw = (unsigned)wid * 1024u;
    const int aoff = lds_byte(wr * 64 + fr, fq * 8), boff = lds_byte(wc * 32 + fr, fq * 8);
#define PG8_SA(b, h) (((b) * 2 + (h)) * HTB)
#define PG8_SB(b, h) ((4 + (b) * 2 + (h)) * HTB)
#define PG8_STAGE(bufoff, gbase, voff) do { _Pragma("unroll") for (int _i = 0; _i < 2; ++_i) \
        __builtin_amdgcn_global_load_lds((const unsigned*)((const char*)(gbase) + (voff)[_i]), (PG8_LAS unsigned*)(lds + (bufoff) + ldsw + _i * 8192), 16, 0, 0); } while (0)
#define PG8_LDA(dst, b, h) do { _Pragma("unroll") for (int m = 0; m < 4; ++m) _Pragma("unroll") for (int k = 0; k < 2; ++k) dst[m][k] = *(const PG8_LAS bf16x8*)(lds + PG8_SA(b, h) + aoff + m * 2048 + k * 1024); } while (0)
#define PG8_LDB(dst, b, h) do { _Pragma("unroll") for (int n = 0; n < 2; ++n) _Pragma("unroll") for (int k = 0; k < 2; ++k) dst[n][k] = *(const PG8_LAS bf16x8*)(lds + PG8_SB(b, h) + boff + n * 2048 + k * 1024); } while (0)
#define PG8_MMA(ai, bj, At, Bt) do { __builtin_amdgcn_s_setprio(1); _Pragma("unroll") for (int m = 0; m < 4; ++m) _Pragma("unroll") for (int n = 0; n < 2; ++n) _Pragma("unroll") for (int k = 0; k < 2; ++k) \
        acc[ai][bj][m][n] = __builtin_amdgcn_mfma_f32_16x16x32_bf16(Bt[n][k], At[m][k], acc[ai][bj][m][n], 0, 0, 0); __builtin_amdgcn_s_setprio(0); } while (0)
#define PG8_WAIT_V(n) asm volatile("s_waitcnt vmcnt(" #n ")" ::: "memory")
#define PG8_WAIT_L(n) asm volatile("s_waitcnt lgkmcnt(" #n ")" ::: "memory")
#define PG8_BAR __builtin_amdgcn_s_barrier()
#define PG8_SCHED __builtin_amdgcn_sched_barrier(0)
    Unit cur, nxt; int ui = 0;
    if (!S.next(0, cur)) return;
    f32x4 acc[2][2][4][2];
#pragma unroll
    for (int a = 0; a < 2; ++a)
#pragma unroll
        for (int b = 0; b < 2; ++b)
#pragma unroll
            for (int m = 0; m < 4; ++m)
#pragma unroll
                for (int n = 0; n < 2; ++n) acc[a][b][m][n] = (f32x4){0.f, 0.f, 0.f, 0.f};
    bf16x8 At[4][2], B0[2][2], B1[2][2];
    const char* cA = (const char*)g.A + (size_t)cur.pm * tstep; const char* cB = (const char*)g.Bt + (size_t)cur.pn * tstep;
    S.a_ready(cur);
    if constexpr (SP2) {
        PG8_STAGE(PG8_SB(0, 0), cB, voffB); PG8_STAGE(PG8_SB(0, 1), cB + hstep, voffB); PG8_STAGE(PG8_SA(0, 0), cA, voffA); PG8_STAGE(PG8_SA(0, 1), cA + hstep, voffA);
        if (wr == 1) PG8_BAR;
        PG8_WAIT_V(2); PG8_BAR;
        PG8_STAGE(PG8_SB(1, 0), cB + kstep, voffB); PG8_STAGE(PG8_SA(1, 0), cA + kstep, voffA); PG8_STAGE(PG8_SB(1, 1), cB + hstep + kstep, voffB);
        PG8_WAIT_V(6); PG8_BAR;
    } else {
        PG8_STAGE(PG8_SB(0, 0), cB, voffB); PG8_STAGE(PG8_SA(0, 0), cA, voffA); PG8_STAGE(PG8_SB(0, 1), cB + hstep, voffB); PG8_STAGE(PG8_SA(0, 1), cA + hstep, voffA);
        if (wr == 1) PG8_BAR;
        PG8_WAIT_V(4); PG8_BAR;
        PG8_STAGE(PG8_SB(1, 0), cB + kstep, voffB); PG8_STAGE(PG8_SA(1, 0), cA + kstep, voffA); PG8_STAGE(PG8_SB(1, 1), cB + hstep + kstep, voffB);
        PG8_WAIT_V(6); PG8_BAR;
    }
    for (;;) {
        const bool has_next = S.next(ui + 1, nxt);
        const char* nA = has_next ? (const char*)g.A + (size_t)nxt.pm * tstep : cA; const char* nB = has_next ? (const char*)g.Bt + (size_t)nxt.pn * tstep : cB;
        for (int t = 0; t < nt; t += 2) {
            const bool last = (t == nt - 2);
            const char* a1 = cA + (size_t)(t + 1) * kstep;
            const char* a2 = last ? nA : cA + (size_t)(t + 2) * kstep; const char* b2 = last ? nB : cB + (size_t)(t + 2) * kstep;
            const char* a3 = a2 + kstep; const char* b3 = b2 + kstep;
            if (last && has_next) S.a_ready(nxt);
            if constexpr (SP2) {
            PG8_LDB(B0, 0, 0); PG8_LDB(B1, 0, 1); PG8_SCHED; PG8_LDA(At, 0, 0); PG8_STAGE(PG8_SA(1, 1), a1 + hstep, voffA);
            PG8_WAIT_V(8); PG8_WAIT_L(0); PG8_BAR; PG8_MMA(0, 0, At, B0); PG8_MMA(0, 1, At, B1); PG8_BAR; PG8_SCHED;
            PG8_LDA(At, 0, 1); PG8_STAGE(PG8_SB(0, 0), b2, voffB); PG8_STAGE(PG8_SB(0, 1), b2 + hstep, voffB); PG8_STAGE(PG8_SA(0, 0), a2, voffA);
            PG8_WAIT_V(8); PG8_WAIT_L(0); PG8_BAR; PG8_MMA(1, 0, At, B0); PG8_MMA(1, 1, At, B1); PG8_BAR; PG8_SCHED;
            PG8_LDB(B0, 1, 0); PG8_LDB(B1, 1, 1); PG8_SCHED; PG8_LDA(At, 1, 0); PG8_STAGE(PG8_SA(0, 1), a2 + hstep, voffA);
            PG8_WAIT_V(8); PG8_WAIT_L(0); PG8_BAR; PG8_MMA(0, 0, At, B0); PG8_MMA(0, 1, At, B1); PG8_BAR; PG8_SCHED;
            PG8_LDA(At, 1, 1); PG8_STAGE(PG8_SB(1, 0), b3, voffB); PG8_STAGE(PG8_SB(1, 1), b3 + hstep, voffB); PG8_STAGE(PG8_SA(1, 0), a3, voffA);
            PG8_WAIT_V(8); PG8_WAIT_L(0); PG8_BAR; PG8_MMA(1, 0, At, B0); PG8_MMA(1, 1, At, B1); PG8_BAR; PG8_SCHED;
            } else {
            PG8_LDB(B0, 0, 0); PG8_SCHED; PG8_LDA(At, 0, 0); PG8_STAGE(PG8_SA(1, 1), a1 + hstep, voffA);
            PG8_WAIT_L(8); PG8_BAR; PG8_WAIT_L(0); PG8_MMA(0, 0, At, B0); PG8_BAR; PG8_SCHED;
            PG8_LDB(B1, 0, 1); PG8_STAGE(PG8_SB(0, 0), b2, voffB);
            PG8_BAR; PG8_WAIT_L(0); PG8_MMA(0, 1, At, B1); PG8_BAR;
            PG8_LDA(At, 0, 1); PG8_STAGE(PG8_SA(0, 0), a2, voffA);
            PG8_BAR; PG8_WAIT_L(0); PG8_MMA(1, 0, At, B0); PG8_BAR; PG8_SCHED;
            PG8_STAGE(PG8_SB(0, 1), b2 + hstep, voffB);
            PG8_WAIT_V(6); PG8_BAR; PG8_MMA(1, 1, At, B1); PG8_BAR;
            PG8_LDB(B0, 1, 0); PG8_SCHED; PG8_LDA(At, 1, 0); PG8_STAGE(PG8_SA(0, 1), a2 + hstep, voffA);
            PG8_WAIT_L(8); PG8_BAR; PG8_WAIT_L(0); PG8_MMA(0, 0, At, B0); PG8_BAR; PG8_SCHED;
            PG8_LDB(B1, 1, 1); PG8_STAGE(PG8_SB(1, 0), b3, voffB);
            PG8_BAR; PG8_WAIT_L(0); PG8_MMA(0, 1, At, B1); PG8_BAR;
            PG8_LDA(At, 1, 1); PG8_STAGE(PG8_SA(1, 0), a3, voffA);
            PG8_BAR; PG8_WAIT_L(0); PG8_MMA(1, 0, At, B0); PG8_BAR; PG8_SCHED;
            PG8_STAGE(PG8_SB(1, 1), b3 + hstep, voffB);
            PG8_WAIT_V(6); PG8_BAR; PG8_MMA(1, 1, At, B1); PG8_BAR;
            }
        }
        if constexpr (ALIGN_EPI) { if (wr == 0) PG8_BAR; }
        if constexpr (!Epi::AFTER_DRAIN) { E(acc, cur, wr, wc, fr, fq); S.done(cur); }
        if (!has_next) break;
#pragma unroll
        for (int a = 0; a < 2; ++a)
#pragma unroll
            for (int b = 0; b < 2; ++b)
#pragma unroll
                for (int m = 0; m < 4; ++m)
#pragma unroll
                    for (int n = 0; n < 2; ++n) acc[a][b][m][n] = (f32x4){0.f, 0.f, 0.f, 0.f};
        cur = nxt; cA = nA; cB = nB; ++ui;
        if constexpr (ALIGN_EPI) { if (wr == 1) PG8_BAR; }
    }
    PG8_WAIT_V(0);
    if constexpr (!ALIGN_EPI) { if (wr == 0) PG8_BAR; }
    PG8_BAR;
    if constexpr (Epi::AFTER_DRAIN) { E.fused(acc, cur, wr, wc, fr, fq, lds, wid, lane); S.done(cur); }
#undef PG8_SA
#undef PG8_SB
#undef PG8_STAGE
#undef PG8_LDA
#undef PG8_LDB
#undef PG8_MMA
#undef PG8_WAIT_V
#undef PG8_WAIT_L
#undef PG8_BAR
#undef PG8_SCHED
}
}

constexpr int DM = 2048, MP = 8192, MS = 512, MT = MP + MS, SEQ = 2048, TS = 16, PAST = 1024, NH = 8, HD = 128;
constexpr int N1 = 8192, LDW0 = 8200, N3 = 12288, CW = 4096, NG = 16, GD = 256, CCH = 128;
constexpr float RMS_EPS = 1e-6f, LN_EPS = 1e-5f, LOG2E = 1.4426950408889634f;
constexpr float QSCALE = 0.08838834764831845f * 1.4426950408889634f;
constexpr size_t O_YP = 0, O_YS = O_YP + (size_t)MP * DM, O_FKP = O_YS + (size_t)MS * DM, O_FVP = O_FKP + (size_t)MP * 1024, O_FLP = O_FVP + (size_t)MP * 1024,
    O_FKS = O_FLP + (size_t)MP * 8, O_FVS = O_FKS + (size_t)MS * 1024, O_FLS = O_FVS + (size_t)MS * 1024, O_SKP = O_FLS + (size_t)MS * 8, O_SVP = O_SKP + (size_t)MP * 1024,
    O_SKS = O_SVP + (size_t)MP * 1024, O_SVS = O_SKS + (size_t)MS * 1024, O_SGV = O_SVS + (size_t)MS * 1024, O_END = O_SGV + (size_t)MS * CW;
constexpr size_t MiB = 1u << 20;
constexpr size_t WS_STAT = 0, WS_W0T = 1 * MiB, WS_WO0T = 33 * MiB, WS_W1T = 41 * MiB, WS_WO1T = 89 * MiB, WS_XN = 105 * MiB, WS_P1 = 139 * MiB, WS_MIX = 275 * MiB,
    WS_UVZ = 105 * MiB  , WS_H1 = 309 * MiB, WS_A1 = 377 * MiB, WS_ACT = 411 * MiB, WS_END = 479 * MiB;
constexpr int ST_SSQ1 = 0, ST_VSUM = 16384, ST_VSQ = 32768, ST_SSQ2 = 49152;
constexpr int LDS_BYTES = 131072 + 16384;

typedef unsigned short bf16_t;
typedef short bf16x8 __attribute__((ext_vector_type(8)));
typedef short s16x4 __attribute__((ext_vector_type(4)));
typedef float f32x4 __attribute__((ext_vector_type(4)));
typedef float f32x8 __attribute__((ext_vector_type(8)));
typedef float f32x16 __attribute__((ext_vector_type(16)));
typedef unsigned u32x4 __attribute__((ext_vector_type(4)));
typedef unsigned u32x2 __attribute__((ext_vector_type(2)));
#define LAS __attribute__((address_space(3)))
#define SBAR() __builtin_amdgcn_sched_barrier(0)

struct Params {
    const float *x_prompt, *x_sample, *cfk, *cfv, *cflogf, *csk, *csv, *norm0_g, *w_in0, *b_forget, *w_out0, *norm1_g, *w_in1, *ln_g, *ln_b, *w_sp, *b_sp, *w_out1, *final_g;
    float* out; unsigned char* ws; int ph_lo, ph_hi;
};

__device__ __forceinline__ unsigned cvtpk(float lo, float hi) { unsigned r; asm volatile("v_cvt_pk_bf16_f32 %0, %1, %2" : "=v"(r) : "v"(lo), "v"(hi)); return r; }
__device__ __forceinline__ float wave_sum(float v) {
#pragma unroll
    for (int o = 1; o < 64; o <<= 1) v += __shfl_xor(v, o);
    return v;
}
__device__ __forceinline__ float bf2f(short s) { return __uint_as_float(((unsigned)(unsigned short)s) << 16); }
__device__ __forceinline__ float silu_f(float g) { return g / (1.f + __expf(-g)); }

using pg8::Unit;
struct Epi1 {
    static constexpr bool PERM = true, AFTER_DRAIN = false;
    bf16_t* P1; float* out;
    __device__ __forceinline__ void operator()(const f32x4 (&acc)[2][2][4][2], const Unit& u, int wr, int wc, int fr, int fq) const {
        const int colt = u.pn * 256, seg = colt >> 10; const bool samp = u.pm >= 32;
        const float sc = (seg == 0 || seg == 4) ? QSCALE : 1.f;
        float* fdst = nullptr;
        if (seg == 1) fdst = out + (samp ? O_FKS : O_FKP); else if (seg == 2) fdst = out + (samp ? O_FVS : O_FVP);
        else if (seg == 5) fdst = out + (samp ? O_SKS : O_SKP); else if (seg == 6) fdst = out + (samp ? O_SVS : O_SVP);
        const int row0 = u.pm * 256 + wr * 64 + fr, col0 = colt + wc * 32 + 8 * fq, lro = samp ? MP : 0;
#pragma unroll
        for (int ai = 0; ai < 2; ++ai)
#pragma unroll
            for (int m = 0; m < 4; ++m) { const int row = row0 + ai * 128 + m * 16; bf16_t* rowp = P1 + (size_t)row * N1 + col0;
#pragma unroll
                for (int bj = 0; bj < 2; ++bj) { const f32x4 v0 = acc[ai][bj][m][0], v1 = acc[ai][bj][m][1];
                    u32x4 w; w.x = cvtpk(v0[0] * sc, v0[1] * sc); w.y = cvtpk(v0[2] * sc, v0[3] * sc); w.z = cvtpk(v1[0] * sc, v1[1] * sc); w.w = cvtpk(v1[2] * sc, v1[3] * sc);
                    *(u32x4*)(rowp + bj * 128) = w;
                    if (fdst) { float* d = fdst + (size_t)(row - lro) * 1024 + (col0 & 1023) + bj * 128; *(f32x4*)d = v0; *(f32x4*)(d + 4) = v1; } } }
    }
};
struct Epi2 {
    static constexpr bool PERM = false, AFTER_DRAIN = false;
    const float *xp, *xs, *g1; float* H1; bf16_t* A1; float* ssq;
    __device__ __forceinline__ void operator()(const f32x4 (&acc)[2][2][4][2], const Unit& u, int wr, int wc, int fr, int fq) const {
        const int col0 = u.pn * 256 + wc * 32 + 4 * fq;
#pragma unroll
        for (int ai = 0; ai < 2; ++ai)
#pragma unroll
            for (int m = 0; m < 4; ++m) { const int row = u.pm * 256 + ai * 128 + wr * 64 + m * 16 + fr;
                const float* xr = row < MP ? xp + (size_t)row * DM : xs + (size_t)(row - MP) * DM; float s = 0.f;
#pragma unroll
                for (int bj = 0; bj < 2; ++bj)
#pragma unroll
                    for (int n = 0; n < 2; ++n) { const int c = col0 + bj * 128 + n * 16; const f32x4 hv = *(const f32x4*)(xr + c) + acc[ai][bj][m][n];
                        *(f32x4*)(H1 + (size_t)row * DM + c) = hv; s += (hv[0] * hv[0] + hv[1] * hv[1]) + (hv[2] * hv[2] + hv[3] * hv[3]);
                        const f32x4 gv = *(const f32x4*)(g1 + c); u32x2 w; w.x = cvtpk(hv[0] * gv[0], hv[1] * gv[1]); w.y = cvtpk(hv[2] * gv[2], hv[3] * gv[3]);
                        *(u32x2*)(A1 + (size_t)row * DM + c) = w; }
                s += __shfl_xor(s, 16); s += __shfl_xor(s, 32);
                if (fq == 0) unsafeAtomicAdd(ssq + row, s); }
    }
};
struct Epi3 {
    static constexpr bool PERM = true, AFTER_DRAIN = false;
    const float* ssq1; bf16_t* UVZ; float *vsum, *vsq;
    __device__ __forceinline__ void operator()(const f32x4 (&acc)[2][2][4][2], const Unit& u, int wr, int wc, int fr, int fq) const {
        const int colt = u.pn * 256, seg = colt >> 12; const int row0 = u.pm * 256 + wr * 64 + fr, col0 = colt + wc * 32 + 8 * fq;
#pragma unroll
        for (int ai = 0; ai < 2; ++ai)
#pragma unroll
            for (int m = 0; m < 4; ++m) { const int row = row0 + ai * 128 + m * 16; const float rs = rsqrtf(ssq1[row] * (1.f / DM) + RMS_EPS);
                bf16_t* rowp = UVZ + (size_t)row * N3 + col0; float s = 0.f, q = 0.f;
#pragma unroll
                for (int bj = 0; bj < 2; ++bj) { const f32x4 v0 = acc[ai][bj][m][0] * rs, v1 = acc[ai][bj][m][1] * rs;
                    u32x4 w; w.x = cvtpk(v0[0], v0[1]); w.y = cvtpk(v0[2], v0[3]); w.z = cvtpk(v1[0], v1[1]); w.w = cvtpk(v1[2], v1[3]);
                    *(u32x4*)(rowp + bj * 128) = w;
                    s += ((v0[0] + v0[1]) + (v0[2] + v0[3])) + ((v1[0] + v1[1]) + (v1[2] + v1[3]));
                    q += ((v0[0] * v0[0] + v0[1] * v0[1]) + (v0[2] * v0[2] + v0[3] * v0[3])) + ((v1[0] * v1[0] + v1[1] * v1[1]) + (v1[2] * v1[2] + v1[3] * v1[3])); }
                if (seg == 1) { s += __shfl_xor(s, 16); s += __shfl_xor(s, 32); q += __shfl_xor(q, 16); q += __shfl_xor(q, 32);
                    if (fq == 0) { unsafeAtomicAdd(vsum + row, s); unsafeAtomicAdd(vsq + row, q); } } }
    }
};
struct Epi4 {
    static constexpr bool PERM = false, AFTER_DRAIN = false;
    const float* H1; float* out; float* ssq;
    __device__ __forceinline__ void operator()(const f32x4 (&acc)[2][2][4][2], const Unit& u, int wr, int wc, int fr, int fq) const {
        const int col0 = u.pn * 256 + wc * 32 + 4 * fq;
#pragma unroll
        for (int ai = 0; ai < 2; ++ai)
#pragma unroll
            for (int m = 0; m < 4; ++m) { const int row = u.pm * 256 + ai * 128 + wr * 64 + m * 16 + fr; float s = 0.f;
#pragma unroll
                for (int bj = 0; bj < 2; ++bj)
#pragma unroll
                    for (int n = 0; n < 2; ++n) { const int c = col0 + bj * 128 + n * 16; const f32x4 hv = *(const f32x4*)(H1 + (size_t)row * DM + c) + acc[ai][bj][m][n];
                        *(f32x4*)(out + (size_t)row * DM + c) = hv; s += (hv[0] * hv[0] + hv[1] * hv[1]) + (hv[2] * hv[2] + hv[3] * hv[3]); }
                s += __shfl_xor(s, 16); s += __shfl_xor(s, 32);
                if (fq == 0) unsafeAtomicAdd(ssq + row, s); }
    }
};

#define KSWZ(row, colB) ((row) * 256 + ((colB) ^ (((row) & 7) << 4)))
__device__ __forceinline__ int crow(int r, int hi) { return (r & 3) + 8 * (r >> 2) + 4 * hi; }
__device__ __forceinline__ bf16x8 tobf8(f32x8 x) { u32x4 w = {cvtpk(x[0], x[1]), cvtpk(x[2], x[3]), cvtpk(x[4], x[5]), cvtpk(x[6], x[7])}; return *reinterpret_cast<bf16x8*>(&w); }
__device__ __forceinline__ f32x8 tof8(bf16x8 x) { f32x8 r;
#pragma unroll
    for (int i = 0; i < 8; ++i) r[i] = bf2f(x[i]); return r; }
__device__ __forceinline__ void qkt(f32x16& p0, f32x16& p1, const char* Ks, const char* Qs, int r32, int hi) {
#pragma unroll
    for (int d0 = 0; d0 < 8; ++d0) { const int cb = (d0 * 16 + hi * 8) * 2;
        const bf16x8 qv = *reinterpret_cast<const bf16x8*>(Qs + KSWZ(r32, cb));
        const bf16x8 b0 = *reinterpret_cast<const bf16x8*>(Ks + KSWZ(r32, cb));
        const bf16x8 b1 = *reinterpret_cast<const bf16x8*>(Ks + KSWZ(32 + r32, cb));
        p0 = __builtin_amdgcn_mfma_f32_32x32x16_bf16(b0, qv, p0, 0, 0, 0);
        p1 = __builtin_amdgcn_mfma_f32_32x32x16_bf16(b1, qv, p1, 0, 0, 0); }
}
__device__ __forceinline__ int v_st(int k, int c) { const int kk = (k & ~0xC) | ((k & 4) << 1) | ((k & 8) >> 1); return ((kk >> 3) * 4 + (c >> 5)) * 512 + ((kk & 7) * 32 + (c & 31)) * 2; }
__device__ __forceinline__ int v_rd_base(int lane) { return ((lane & 3) << 3) | (((lane >> 2) & 3) << 6) | (((lane >> 4) & 1) << 5) | (((lane >> 5) & 1) << 8); }
constexpr int v_rd_off(int d0, int ks, int half) { return d0 * 512 + ks * 4096 + half * 2048; }
template <int OFF> __device__ __forceinline__ s16x4 tr_read(int vb) { s16x4 r; asm volatile("ds_read_b64_tr_b16 %0, %1 offset:%2" : "=&v"(r) : "v"(vb), "i"(OFF) : "memory"); return r; }
template <int D0> __device__ __forceinline__ void pv_one(f32x16& od, int vb, bf16x8 pa0, bf16x8 pa1, bf16x8 pa2, bf16x8 pa3) {
    const s16x4 l0 = tr_read<v_rd_off(D0, 0, 0)>(vb), h0 = tr_read<v_rd_off(D0, 0, 1)>(vb), l1 = tr_read<v_rd_off(D0, 1, 0)>(vb), h1 = tr_read<v_rd_off(D0, 1, 1)>(vb);
    const s16x4 l2 = tr_read<v_rd_off(D0, 2, 0)>(vb), h2 = tr_read<v_rd_off(D0, 2, 1)>(vb), l3 = tr_read<v_rd_off(D0, 3, 0)>(vb), h3 = tr_read<v_rd_off(D0, 3, 1)>(vb);
    asm volatile("s_waitcnt lgkmcnt(0)" ::: "memory"); SBAR();
#define PKV(L, H) (bf16x8){L[0], L[1], L[2], L[3], H[0], H[1], H[2], H[3]}
    od = __builtin_amdgcn_mfma_f32_32x32x16_bf16(pa0, PKV(l0, h0), od, 0, 0, 0);
    od = __builtin_amdgcn_mfma_f32_32x32x16_bf16(pa1, PKV(l1, h1), od, 0, 0, 0);
    od = __builtin_amdgcn_mfma_f32_32x32x16_bf16(pa2, PKV(l2, h2), od, 0, 0, 0);
    od = __builtin_amdgcn_mfma_f32_32x32x16_bf16(pa3, PKV(l3, h3), od, 0, 0, 0);
#undef PKV
}
__device__ __forceinline__ void pv_d0(f32x16* o, int vb, bf16x8 pa0, bf16x8 pa1, bf16x8 pa2, bf16x8 pa3) {
    pv_one<0>(o[0], vb, pa0, pa1, pa2, pa3); pv_one<1>(o[1], vb, pa0, pa1, pa2, pa3); pv_one<2>(o[2], vb, pa0, pa1, pa2, pa3); pv_one<3>(o[3], vb, pa0, pa1, pa2, pa3);
}
#define PK4(P, BASE, OUT) do { unsigned a0_ = cvtpk(P[BASE + 0], P[BASE + 1]), a1_ = cvtpk(P[BASE + 2], P[BASE + 3]);   \
    unsigned b0_ = cvtpk(P[BASE + 4], P[BASE + 5]), b1_ = cvtpk(P[BASE + 6], P[BASE + 7]);                              \
    auto r0_ = __builtin_amdgcn_permlane32_swap(a0_, b0_, false, false); auto r1_ = __builtin_amdgcn_permlane32_swap(a1_, b1_, false, false); \
    u32x4 w_ = {r0_[0], r1_[0], r0_[1], r1_[1]}; OUT = *reinterpret_cast<bf16x8*>(&w_); } while (0)

constexpr int AL_K = 0, AL_V = 32768, AL_BIAS = 65536, AL_WS = 73728, AL_SCAN = 75776, AL_Q = 77824;

template <int MODE, bool SAMPLE>
__device__ __forceinline__ void attn_unit(const Params& p, char* lds, int b, int h, int qb) {
    const int tid = threadIdx.x, wid = __builtin_amdgcn_readfirstlane(tid >> 6), lane = tid & 63, r32 = lane & 31, hi = lane >> 5;
    char* K_lds = lds + AL_K; char* V_lds = lds + AL_V; float* biasL = (float*)(lds + AL_BIAS); float* wsc = (float*)(lds + AL_WS) + wid * 64; float* scanL = (float*)(lds + AL_SCAN);
    const bf16_t* P1 = (const bf16_t*)(p.ws + WS_P1);
    const int qcol = (MODE ? 4096 : 0) + h * HD;
    if (MODE == 0) {
        float v[4];
#pragma unroll
        for (int i = 0; i < 4; ++i) { const int pos = 4 * tid + i; float x = 0.f;
            if (SAMPLE) { if (pos < PAST) x = p.cflogf[((size_t)b * PAST + pos) * NH + h]; else if (pos < PAST + TS) x = p.out[O_FLS + ((size_t)b * TS + pos - PAST) * NH + h]; }
            else { if (pos < 256 * (qb + 1)) x = p.out[O_FLP + ((size_t)b * SEQ + pos) * NH + h]; }
            v[i] = x; }
        const float s0 = v[0], s1 = s0 + v[1], s2 = s1 + v[2], s3 = s2 + v[3]; float incl = s3;
#pragma unroll
        for (int o = 1; o < 64; o <<= 1) { const float t = __shfl_up(incl, o); if (lane >= o) incl += t; }
        if (lane == 63) scanL[wid] = incl;
        __syncthreads();
        float base = incl - s3;
#pragma unroll
        for (int w = 0; w < 8; ++w) if (w < wid) base += scanL[w];
        f32x4 bv = {-(base + s0) * LOG2E, -(base + s1) * LOG2E, -(base + s2) * LOG2E, -(base + s3) * LOG2E};
        *(f32x4*)(biasL + 4 * tid) = bv;
        __syncthreads();
    }
    const size_t qrow = SAMPLE ? (size_t)(MP + b * TS + (r32 & 15)) : (size_t)(b * SEQ + qb * 256 + wid * 32 + r32);
    const bf16_t* Qw = P1 + qrow * N1 + qcol + hi * 8;
    char* Qs = lds + AL_Q + wid * 8192;
#pragma unroll
    for (int d0 = 0; d0 < 8; ++d0) *reinterpret_cast<bf16x8*>(Qs + KSWZ(r32, (d0 * 16 + hi * 8) * 2)) = *reinterpret_cast<const bf16x8*>(Qw + d0 * 16);
    const int qw0 = SAMPLE ? PAST : qb * 256 + wid * 32;
    const int qpos = SAMPLE ? PAST + (r32 & 15) : qw0 + r32;
    const int jd = SAMPLE ? 16 : (qw0 >> 6);
    const int jfirst = SAMPLE ? 16 : qb * 4 + 3;
    const bool wact = SAMPLE ? (wid == 0) : true;
    const int sr = tid >> 4, sc = (tid & 15) * 8;
    const int vst0 = v_st(sr, sc), vst1 = v_st(32 + sr, sc), kst0 = KSWZ(sr, sc * 2), kst1 = KSWZ(32 + sr, sc * 2);
    const int vb0 = (int)(uintptr_t)V_lds + v_rd_base(lane);
    bf16x8 sk0, sk1, sv0, sv1; f32x8 fk0, fk1, fv0, fv1;
    const float* cK = MODE ? p.csk : p.cfk; const float* cV = MODE ? p.csv : p.cfv;
#define LOADT(j) do { if (!SAMPLE) { const bf16_t* kb_ = P1 + (size_t)(b * SEQ + (j) * 64) * N1 + qcol + 1024 + sc;                                   \
        sk0 = *(const bf16x8*)(kb_ + (size_t)sr * N1); sk1 = *(const bf16x8*)(kb_ + (size_t)(sr + 32) * N1);                                           \
        sv0 = *(const bf16x8*)(kb_ + 1024 + (size_t)sr * N1); sv1 = *(const bf16x8*)(kb_ + 1024 + (size_t)(sr + 32) * N1); }                           \
    else if ((j) < 16) { const size_t o_ = (((size_t)b * PAST + (j) * 64) * NH + h) * HD + sc;                                                        \
        fk0 = *(const f32x8*)(cK + o_ + (size_t)sr * 1024); fk1 = *(const f32x8*)(cK + o_ + (size_t)(sr + 32) * 1024);                                 \
        fv0 = *(const f32x8*)(cV + o_ + (size_t)sr * 1024); fv1 = *(const f32x8*)(cV + o_ + (size_t)(sr + 32) * 1024); }                               \
    else { const bf16_t* kb_ = P1 + (size_t)(MP + b * TS) * N1 + qcol + 1024 + sc; const int ra_ = sr < 15 ? sr : 15;                                   \
        fk0 = tof8(*(const bf16x8*)(kb_ + (size_t)ra_ * N1)); fk1 = tof8(*(const bf16x8*)(kb_ + (size_t)15 * N1));                                     \
        fv0 = tof8(*(const bf16x8*)(kb_ + 1024 + (size_t)ra_ * N1)); fv1 = tof8(*(const bf16x8*)(kb_ + 1024 + (size_t)15 * N1)); } } while (0)
#define WRITET(buf) do { if (!SAMPLE) { *(bf16x8*)(K_lds + (buf) * 16384 + kst0) = sk0; *(bf16x8*)(K_lds + (buf) * 16384 + kst1) = sk1;               \
        *(bf16x8*)(V_lds + (buf) * 16384 + vst0) = sv0; *(bf16x8*)(V_lds + (buf) * 16384 + vst1) = sv1; }                                              \
    else { *(bf16x8*)(K_lds + (buf) * 16384 + kst0) = tobf8(fk0); *(bf16x8*)(K_lds + (buf) * 16384 + kst1) = tobf8(fk1);                               \
        *(bf16x8*)(V_lds + (buf) * 16384 + vst0) = tobf8(fv0); *(bf16x8*)(V_lds + (buf) * 16384 + vst1) = tobf8(fv1); } } while (0)
    f32x16 o[4] = {};
    float m_reg = -1e30f, l_reg = 0.f, carry = 0.f;
    LOADT(jfirst);
    for (int j = jfirst; j >= 0; --j) {
        const int buf = j & 1;
        WRITET(buf);
        if (j > 0) LOADT(j - 1);
        __syncthreads();
        if (wact && j <= jd) {
            const char* Kt = K_lds + buf * 16384; const int vb = vb0 + buf * 16384;
            f32x16 p0, p1; bf16x8 pa0, pa1, pa2, pa3;
            if (MODE == 0) {
                const float* bt = biasL + j * 64 + 4 * hi;
#pragma unroll
                for (int g = 0; g < 4; ++g) { const f32x4 a = *(const f32x4*)(bt + 8 * g), c = *(const f32x4*)(bt + 32 + 8 * g);
#pragma unroll
                    for (int i = 0; i < 4; ++i) { p0[4 * g + i] = a[i]; p1[4 * g + i] = c[i]; } }
                qkt(p0, p1, Kt, Qs, r32, hi);
                if (j == jd) {
#pragma unroll
                    for (int r = 0; r < 16; ++r) { const int kp = j * 64 + crow(r, hi); if (kp > qpos) p0[r] = -1e30f; if (kp + 32 > qpos) p1[r] = -1e30f; } }
                float pmax = p0[0];
#pragma unroll
                for (int r = 1; r < 16; ++r) pmax = fmaxf(pmax, p0[r]);
#pragma unroll
                for (int r = 0; r < 16; ++r) pmax = fmaxf(pmax, p1[r]);
                { auto rr = __builtin_amdgcn_permlane32_swap(__float_as_uint(pmax), __float_as_uint(pmax), false, false); pmax = fmaxf(__uint_as_float(rr[0]), __uint_as_float(rr[1])); }
                float alpha = 1.f;
                if (!__all(pmax - m_reg <= 8.f)) { const float mn = fmaxf(m_reg, pmax); alpha = __builtin_amdgcn_exp2f(m_reg - mn); m_reg = mn; }
                float ps = 0.f;
#pragma unroll
                for (int r = 0; r < 16; ++r) { p0[r] = __builtin_amdgcn_exp2f(p0[r] - m_reg); p1[r] = __builtin_amdgcn_exp2f(p1[r] - m_reg); ps += p0[r] + p1[r]; }
                { auto rr = __builtin_amdgcn_permlane32_swap(__float_as_uint(ps), __float_as_uint(ps), false, false); ps = __uint_as_float(rr[0]) + __uint_as_float(rr[1]); }
                l_reg = l_reg * alpha + ps;
                if (__any(alpha < 1.f)) { if (hi == 0) wsc[r32] = alpha; asm volatile("s_waitcnt lgkmcnt(0)" ::: "memory");
#pragma unroll
                    for (int d = 0; d < 4; ++d)
#pragma unroll
                        for (int r = 0; r < 16; ++r) o[d][r] *= wsc[crow(r, hi)]; }
            } else {
                p0 = f32x16{}; p1 = f32x16{};
                qkt(p0, p1, Kt, Qs, r32, hi);
                f32x16 s0, s1;
#pragma unroll
                for (int r = 0; r < 16; ++r) {
                    s0[r] = fmaxf(p0[r], 0.f) + __builtin_amdgcn_logf(1.f + __builtin_amdgcn_exp2f(-fabsf(p0[r])));
                    s1[r] = fmaxf(p1[r], 0.f) + __builtin_amdgcn_logf(1.f + __builtin_amdgcn_exp2f(-fabsf(p1[r]))); }
                if (j == jd) {
#pragma unroll
                    for (int r = 0; r < 16; ++r) { const int kp = j * 64 + crow(r, hi); if (kp >= qpos) { s0[r] = 0.f; p0[r] = -1e30f; } if (kp + 32 >= qpos) { s1[r] = 0.f; p1[r] = -1e30f; } } }
                float run = carry, bs[8];
#pragma unroll
                for (int i = 7; i >= 0; --i) { const f32x16& S = (i >= 4) ? s1 : s0; const int rb = 4 * (i & 3);
                    const float gs = (S[rb] + S[rb + 1]) + (S[rb + 2] + S[rb + 3]);
                    auto rr = __builtin_amdgcn_permlane32_swap(__float_as_uint(gs), __float_as_uint(gs), false, false);
                    const float glo = __uint_as_float(rr[0]), ghi = __uint_as_float(rr[1]);
                    const float exH = run; run += ghi; const float exL = run; run += glo;
                    bs[i] = hi ? exH : exL; }
                carry = run;
#pragma unroll
                for (int i = 0; i < 8; ++i) { f32x16& S = (i >= 4) ? s1 : s0; f32x16& Z = (i >= 4) ? p1 : p0; const int rb = 4 * (i & 3);
                    const float i3 = bs[i] + S[rb + 3], i2 = i3 + S[rb + 2], i1 = i2 + S[rb + 1], i0 = i1 + S[rb];
                    Z[rb + 3] = __builtin_amdgcn_exp2f(Z[rb + 3] - i3); Z[rb + 2] = __builtin_amdgcn_exp2f(Z[rb + 2] - i2);
                    Z[rb + 1] = __builtin_amdgcn_exp2f(Z[rb + 1] - i1); Z[rb] = __builtin_amdgcn_exp2f(Z[rb] - i0); }
            }
            PK4(p0, 0, pa0); PK4(p0, 8, pa1); PK4(p1, 0, pa2); PK4(p1, 8, pa3);
            pv_d0(o, vb, pa0, pa1, pa2, pa3);
        }
    }
    if (wact) {
        float rli[16];
        if (MODE == 0) { if (hi == 0) wsc[32 + r32] = l_reg; asm volatile("s_waitcnt lgkmcnt(0)" ::: "memory");
#pragma unroll
            for (int r = 0; r < 16; ++r) rli[r] = __builtin_amdgcn_rcpf(wsc[32 + crow(r, hi)]); }
        bf16_t* MIX = (bf16_t*)(p.ws + WS_MIX);
        const size_t rbase = SAMPLE ? (size_t)(MP + b * TS) : (size_t)(b * SEQ + qb * 256 + wid * 32);
#pragma unroll
        for (int r = 0; r < 16; ++r) { const int orow = crow(r, hi);
            if (!SAMPLE || orow < TS) {
#pragma unroll
                for (int d0 = 0; d0 < 4; ++d0) { const int d = d0 * 32 + r32;
                    const float g = bf2f((short)P1[(rbase + orow) * N1 + qcol + 3072 + d]);
                    float ov = o[d0][r]; if (MODE == 0) ov *= rli[r];
                    const unsigned pk = cvtpk(ov * silu_f(g), 0.f);
                    MIX[(rbase + orow) * DM + MODE * 1024 + h * HD + d] = (bf16_t)(pk & 0xffffu); } } }
    }
    __syncthreads();
#undef LOADT
#undef WRITET
}

__device__ __forceinline__ void attn_phase(const Params& p, char* lds) {
    const int G = gridDim.x;
    for (int u = blockIdx.x; u < 256; u += G) {
        const int bh = u & 31, i = u >> 5;
        attn_unit<0, false>(p, lds, bh >> 3, bh & 7, i);
        attn_unit<1, false>(p, lds, bh >> 3, bh & 7, 7 - i);
    }
    for (int u = blockIdx.x; u < 512; u += G) {
        const int bh = u & 255;
        if (u < 256) attn_unit<0, true>(p, lds, bh >> 3, bh & 7, 0); else attn_unit<1, true>(p, lds, bh >> 3, bh & 7, 0);
    }
}

__device__ __forceinline__ void spatial_phase(const Params& p, char* lds) {
    const int tid = threadIdx.x, wid = __builtin_amdgcn_readfirstlane(tid >> 6), lane = tid & 63, r32 = lane & 31, hi = lane >> 5;
    const bf16_t* UVZ = (const bf16_t*)(p.ws + WS_UVZ); bf16_t* ACT = (bf16_t*)(p.ws + WS_ACT);
    const float* st = (const float*)(p.ws + WS_STAT);
    const int sr = tid >> 4, sc = (tid & 15) * 8; const int tb = wid & 3, ch = wid >> 2;
    for (int u = blockIdx.x; u < 1536; u += gridDim.x) {
        const bool samp = u >= 1024; const int g = u & 15, cidx = samp ? ((u - 1024) >> 4) : (u >> 4);
        const size_t rbase = samp ? (size_t)(MP + cidx * TS) : (size_t)cidx * CCH; const int nrows = samp ? TS : CCH;
#pragma unroll
        for (int q = 0; q < 4; ++q) { const int st_ = q >> 1, ch_ = q & 1; if (samp && st_ == 1) continue;
#pragma unroll
            for (int hf = 0; hf < 2; ++hf) { const int k = sr + 32 * hf, s = st_ * 64 + k; const int cc = ch_ * 128 + sc;
                bf16x8 w = {};
                if (s < nrows) { const size_t row = rbase + s; const float mu = st[ST_VSUM + row] * (1.f / CW); const float var = fmaxf(st[ST_VSQ + row] * (1.f / CW) - mu * mu, 0.f); const float rs = rsqrtf(var + LN_EPS);
                    const bf16x8 raw = *(const bf16x8*)(UVZ + row * N3 + CW + g * GD + cc);
                    const f32x4 g0 = *(const f32x4*)(p.ln_g + g * GD + cc), g1 = *(const f32x4*)(p.ln_g + g * GD + cc + 4), b0 = *(const f32x4*)(p.ln_b + g * GD + cc), b1 = *(const f32x4*)(p.ln_b + g * GD + cc + 4);
                    f32x8 y;
#pragma unroll
                    for (int i = 0; i < 4; ++i) { y[i] = (bf2f(raw[i]) - mu) * rs * g0[i] + b0[i]; y[4 + i] = (bf2f(raw[4 + i]) - mu) * rs * g1[i] + b1[i]; }
                    if (samp) { float* d = p.out + O_SGV + (size_t)(cidx * TS + s) * CW + g * GD + cc; *(f32x4*)d = (f32x4){y[0], y[1], y[2], y[3]}; *(f32x4*)(d + 4) = (f32x4){y[4], y[5], y[6], y[7]}; }
                    w = tobf8(y); }
                *(bf16x8*)(lds + q * 16384 + v_st(k, sc)) = w; } }
        __syncthreads();
        const bool act = samp ? (tb == 0) : true;
        if (act) {
            f32x16 o[4] = {};
            const int t = 32 * tb + r32;
            const int nst = (!samp && tb >= 2) ? 2 : 1;
            for (int st_ = 0; st_ < nst; ++st_) {
                bf16x8 pa[4];
#pragma unroll
                for (int ks = 0; ks < 4; ++ks) { const int s0 = 64 * st_ + 16 * ks + 8 * hi; const float* wp = p.w_sp + ((size_t)g * CCH + t) * CCH + s0;
                    const f32x4 a = *(const f32x4*)wp, c = *(const f32x4*)(wp + 4); f32x8 y;
#pragma unroll
                    for (int i = 0; i < 4; ++i) { y[i] = (s0 + i <= t) ? a[i] : 0.f; y[4 + i] = (s0 + 4 + i <= t) ? c[i] : 0.f; }
                    pa[ks] = tobf8(y); }
                const int vb = (int)(uintptr_t)(lds + (st_ * 2 + ch) * 16384) + v_rd_base(lane);
                pv_d0(o, vb, pa[0], pa[1], pa[2], pa[3]);
            }
#pragma unroll
            for (int r = 0; r < 16; ++r) { const int tt = 32 * tb + crow(r, hi);
                if (tt < nrows) { const float bsp = p.b_sp[g * CCH + tt]; const size_t row = rbase + tt;
#pragma unroll
                    for (int d0 = 0; d0 < 4; ++d0) { const int col = g * GD + ch * 128 + d0 * 32 + r32;
                        const float uu = bf2f((short)UVZ[row * N3 + col]), zz = bf2f((short)UVZ[row * N3 + 2 * CW + col]);
                        const unsigned pk = cvtpk(uu * (o[d0][r] + bsp) * silu_f(zz), 0.f);
                        ACT[row * CW + col] = (bf16_t)(pk & 0xffffu); } } }
        }
        __syncthreads();
    }
}

__device__ __forceinline__ unsigned f2bf(float f) { unsigned u = __builtin_bit_cast(unsigned, f); return (u + 0x7fffu + ((u >> 16) & 1u)) >> 16; }
__device__ __forceinline__ unsigned pk2(float lo, float hi) { return f2bf(lo) | (f2bf(hi) << 16); }
__device__ __forceinline__ void p0_transpose_item(const float* W, int ld, int nblk, int K, bf16_t* WT, LAS float* scr, int item, int lane) {
    const int kb = item / nblk, nb = item % nblk, k0 = 64 * kb, n0 = 32 * nb;
    float t[32];
#pragma unroll
    for (int i = 0; i < 32; ++i) { const int kk = 2 * i + (lane >> 5); t[i] = W[(size_t)(k0 + kk) * ld + n0 + (lane & 31)]; }
#pragma unroll
    for (int i = 0; i < 32; ++i) { const int kk = 2 * i + (lane >> 5); scr[kk * 33 + (lane & 31)] = t[i]; }
    asm volatile("s_waitcnt lgkmcnt(0)" ::: "memory");
    const int c = lane & 7;
#pragma unroll
    for (int j = 0; j < 4; ++j) { const int n = (lane >> 3) + 8 * j; const LAS float* s = scr + (8 * c) * 33 + n;
        u32x4 o; o.x = pk2(s[0 * 33], s[1 * 33]); o.y = pk2(s[2 * 33], s[3 * 33]); o.z = pk2(s[4 * 33], s[5 * 33]); o.w = pk2(s[6 * 33], s[7 * 33]);
        *(u32x4*)(WT + (size_t)(n0 + n) * K + k0 + 8 * c) = o; }
    asm volatile("s_waitcnt lgkmcnt(0)" ::: "memory");
}
__device__ __forceinline__ float log_sigmoid_f(float x) { return fminf(x, 0.f) - log1pf(expf(-fabsf(x))); }

__device__ __forceinline__ void prologue_phase(const Params& p, unsigned char* ldsg) {
    const int tid = threadIdx.x, wid = __builtin_amdgcn_readfirstlane(tid >> 6), lane = tid & 63;
    const int gw = blockIdx.x * 8 + wid, NGW = gridDim.x * 8;
    LAS unsigned char* lds = (LAS unsigned char*)ldsg;
    { float* st = (float*)(p.ws + WS_STAT); for (int i = blockIdx.x * 512 + tid; i < 65536; i += gridDim.x * 512) st[i] = 0.f; }
    LAS float* scr = (LAS float*)(lds + wid * 16384);
    constexpr int I0 = (DM / 64) * (N1 / 32), I1 = (DM / 64) * (DM / 32), I2 = (DM / 64) * (N3 / 32), I3 = (CW / 64) * (DM / 32);
    for (int it = gw; it < I0 + I1 + I2 + I3; it += NGW) {
        int r = it;
        if (r < I0) { p0_transpose_item(p.w_in0, LDW0, N1 / 32, DM, (bf16_t*)(p.ws + WS_W0T), scr, r, lane); continue; } r -= I0;
        if (r < I1) { p0_transpose_item(p.w_out0, DM, DM / 32, DM, (bf16_t*)(p.ws + WS_WO0T), scr, r, lane); continue; } r -= I1;
        if (r < I2) { p0_transpose_item(p.w_in1, N3, N3 / 32, DM, (bf16_t*)(p.ws + WS_W1T), scr, r, lane); continue; } r -= I2;
        p0_transpose_item(p.w_out1, DM, DM / 32, CW, (bf16_t*)(p.ws + WS_WO1T), scr, r, lane);
    }
    __syncthreads();
    LAS float* wf = (LAS float*)lds;
    for (int i = tid; i < DM * 8; i += 512) wf[i] = p.w_in0[(size_t)(i >> 3) * LDW0 + N1 + (i & 7)];
    __syncthreads();
    bf16_t* XN = (bf16_t*)(p.ws + WS_XN);
    for (int m = gw; m < MT; m += NGW) {
        const float* xr = m < MP ? p.x_prompt + (size_t)m * DM : p.x_sample + (size_t)(m - MP) * DM;
        f32x4 v[8]; float s = 0.f;
#pragma unroll
        for (int j = 0; j < 8; ++j) { v[j] = *(const f32x4*)(xr + 256 * j + 4 * lane); s += (v[j][0] * v[j][0] + v[j][1] * v[j][1]) + (v[j][2] * v[j][2] + v[j][3] * v[j][3]); }
        const float rstd = rsqrtf(wave_sum(s) * (1.f / DM) + RMS_EPS);
        float fa[8] = {0.f, 0.f, 0.f, 0.f, 0.f, 0.f, 0.f, 0.f};
#pragma unroll
        for (int j = 0; j < 8; ++j) { const f32x4 gv = *(const f32x4*)(p.norm0_g + 256 * j + 4 * lane); v[j] = v[j] * rstd * gv;
            u32x2 w; w.x = cvtpk(v[j][0], v[j][1]); w.y = cvtpk(v[j][2], v[j][3]); *(u32x2*)(XN + (size_t)m * DM + 256 * j + 4 * lane) = w;
#pragma unroll
            for (int i = 0; i < 4; ++i) { const LAS f32x4* wp = (const LAS f32x4*)(wf + (256 * j + 4 * lane + i) * 8); const f32x4 w0 = wp[0], w1 = wp[1];
                fa[0] += v[j][i] * w0[0]; fa[1] += v[j][i] * w0[1]; fa[2] += v[j][i] * w0[2]; fa[3] += v[j][i] * w0[3];
                fa[4] += v[j][i] * w1[0]; fa[5] += v[j][i] * w1[1]; fa[6] += v[j][i] * w1[2]; fa[7] += v[j][i] * w1[3]; } }
        float mine = 0.f;
#pragma unroll
        for (int c = 0; c < 8; ++c) { const float t = wave_sum(fa[c]); if (lane == c) mine = t; }
        if (lane < 8) { const float lf = log_sigmoid_f(mine + p.b_forget[lane]);
            if (m < MP) p.out[O_FLP + (size_t)m * 8 + lane] = lf; else p.out[O_FLS + (size_t)(m - MP) * 8 + lane] = lf; }
    }
    __syncthreads();
}

__device__ __forceinline__ void final_phase(const Params& p) {
    const int tid = threadIdx.x, wid = tid >> 6, lane = tid & 63; const int gw = blockIdx.x * 8 + wid, NGW = gridDim.x * 8;
    const float* ssq2 = (const float*)(p.ws + WS_STAT) + ST_SSQ2;
    for (int m = gw; m < MT; m += NGW) { const float rs = rsqrtf(ssq2[m] * (1.f / DM) + RMS_EPS); float* yr = p.out + (size_t)m * DM;
#pragma unroll
        for (int j = 0; j < 8; ++j) { const f32x4 hv = *(const f32x4*)(yr + 256 * j + 4 * lane), gv = *(const f32x4*)(p.final_g + 256 * j + 4 * lane); *(f32x4*)(yr + 256 * j + 4 * lane) = hv * rs * gv; } }
}

constexpr int NPHASE = 8;
__global__ void __launch_bounds__(512, 2) mega_fwd(Params p) {
    extern __shared__ __attribute__((aligned(16))) unsigned char lds[];
    cg::grid_group grid = cg::this_grid();
    const int lo = p.ph_lo, hi = p.ph_hi;
#define IN(k) (lo <= (k) && (k) < hi)
#define SEAM(k) do { if (IN(k) && IN((k) + 1)) grid.sync(); } while (0)
    float* stat = (float*)(p.ws + WS_STAT);
    if (IN(0)) prologue_phase(p, lds);
    SEAM(0);
    if (IN(1)) { pg8::Gemm g{(const bf16_t*)(p.ws + WS_XN), (const bf16_t*)(p.ws + WS_W0T), MT, N1, DM}; pg8::StaticOrder S; S.init(MT, N1, gridDim.x, blockIdx.x);
        Epi1 E{(bf16_t*)(p.ws + WS_P1), p.out};
        pg8::gemm_phase<Epi1, pg8::StaticOrder, true, true>((PG8_LAS unsigned char*)lds, g, S, E); }
    SEAM(1);
    if (IN(2)) attn_phase(p, (char*)lds);
    SEAM(2);
    if (IN(3)) { pg8::Gemm g{(const bf16_t*)(p.ws + WS_MIX), (const bf16_t*)(p.ws + WS_WO0T), MT, DM, DM}; pg8::StaticOrder S; S.init(MT, DM, gridDim.x, blockIdx.x);
        Epi2 E{p.x_prompt, p.x_sample, p.norm1_g, (float*)(p.ws + WS_H1), (bf16_t*)(p.ws + WS_A1), stat + ST_SSQ1};
        pg8::gemm_phase<Epi2, pg8::StaticOrder, true, true>((PG8_LAS unsigned char*)lds, g, S, E); }
    SEAM(3);
    if (IN(4)) { pg8::Gemm g{(const bf16_t*)(p.ws + WS_A1), (const bf16_t*)(p.ws + WS_W1T), MT, N3, DM}; pg8::StaticOrder S; S.init(MT, N3, gridDim.x, blockIdx.x);
        Epi3 E{stat + ST_SSQ1, (bf16_t*)(p.ws + WS_UVZ), stat + ST_VSUM, stat + ST_VSQ};
        pg8::gemm_phase<Epi3, pg8::StaticOrder, true, true>((PG8_LAS unsigned char*)lds, g, S, E); }
    SEAM(4);
    if (IN(5)) spatial_phase(p, (char*)lds);
    SEAM(5);
    if (IN(6)) { pg8::Gemm g{(const bf16_t*)(p.ws + WS_ACT), (const bf16_t*)(p.ws + WS_WO1T), MT, DM, CW}; pg8::StaticOrder S; S.init(MT, DM, gridDim.x, blockIdx.x);
        Epi4 E{(const float*)(p.ws + WS_H1), p.out, stat + ST_SSQ2};
        pg8::gemm_phase<Epi4, pg8::StaticOrder, true, true>((PG8_LAS unsigned char*)lds, g, S, E); }
    SEAM(6);
    if (IN(7)) final_phase(p);
#undef IN
#undef SEAM
}

extern "C" void kernel_launch(void* const* d_in, const int* in_sizes, int n_in, void* d_out, int out_size, void* d_ws, size_t ws_size, hipStream_t stream) {
    static int grid = 0;
    if (grid == 0) {
        if (n_in != 19 || out_size != (int)O_END || ws_size < WS_END) { fprintf(stderr, "kernel_launch: unexpected shapes: n_in %d out %d (want %zu) ws %zu (want %zu)\n", n_in, out_size, (size_t)O_END, ws_size, (size_t)WS_END); grid = -1; return; }
        int dev = 0, cus = 0, per_cu = 0;
        hipGetDevice(&dev); hipDeviceGetAttribute(&cus, hipDeviceAttributeMultiprocessorCount, dev);
        if (hipFuncSetAttribute((const void*)mega_fwd, hipFuncAttributeMaxDynamicSharedMemorySize, LDS_BYTES) != hipSuccess) { fprintf(stderr, "kernel_launch: hipFuncSetAttribute failed\n"); grid = -1; return; }
        if (hipOccupancyMaxActiveBlocksPerMultiprocessor(&per_cu, (const void*)mega_fwd, 512, LDS_BYTES) != hipSuccess || per_cu < 1) { fprintf(stderr, "kernel_launch: occupancy query failed (%d)\n", per_cu); per_cu = 1; }
        (void)hipGetLastError();
        grid = cus * per_cu;
        fprintf(stderr, "kernel_launch: grid %d (%d CUs x %d)\n", grid, cus, per_cu);
    }
    if (grid < 0) return;
    Params p{};
    p.x_prompt = (const float*)d_in[0]; p.x_sample = (const float*)d_in[1]; p.cfk = (const float*)d_in[2]; p.cfv = (const float*)d_in[3]; p.cflogf = (const float*)d_in[4];
    p.csk = (const float*)d_in[5]; p.csv = (const float*)d_in[6]; p.norm0_g = (const float*)d_in[7]; p.w_in0 = (const float*)d_in[8]; p.b_forget = (const float*)d_in[9];
    p.w_out0 = (const float*)d_in[10]; p.norm1_g = (const float*)d_in[11]; p.w_in1 = (const float*)d_in[12]; p.ln_g = (const float*)d_in[13]; p.ln_b = (const float*)d_in[14];
    p.w_sp = (const float*)d_in[15]; p.b_sp = (const float*)d_in[16]; p.w_out1 = (const float*)d_in[17]; p.final_g = (const float*)d_in[18];
    p.out = (float*)d_out; p.ws = (unsigned char*)d_ws;
#if MK_N_LAUNCHES == 1
    p.ph_lo = 0; p.ph_hi = NPHASE;
    void* args[] = {&p};
    hipError_t e = hipLaunchCooperativeKernel((const void*)mega_fwd, dim3(grid), dim3(512), args, LDS_BYTES, stream);
    if (e != hipSuccess) fprintf(stderr, "kernel_launch: cooperative launch failed: %s (grid %d)\n", hipGetErrorString(e), grid);
#else
    for (int k = 0; k < NPHASE; ++k) { p.ph_lo = k; p.ph_hi = k + 1; hipLaunchKernelGGL(mega_fwd, dim3(grid), dim3(512), LDS_BYTES, stream, p); }
    hipError_t e = hipPeekAtLastError();
    if (e != hipSuccess) fprintf(stderr, "kernel_launch: launch failed: %s\n", hipGetErrorString(e));
#endif
}
```

```cpp
#include <hip/hip_runtime.h>
#include <hip/hip_cooperative_groups.h>
#include <cstdio>
#include <cstdint>
namespace cg = cooperative_groups;

#ifndef MK_N_LAUNCHES
#define MK_N_LAUNCHES 1
#endif
#ifndef REP_PHASE
#define REP_PHASE -1
#endif
namespace pg8 {
#define PG8_LAS __attribute__((address_space(3)))
typedef unsigned short bf16_t;
typedef short bf16x8 __attribute__((ext_vector_type(8)));
typedef float f32x4 __attribute__((ext_vector_type(4)));
typedef unsigned u32x4 __attribute__((ext_vector_type(4)));
constexpr int BM = 256, BK = 64, HALF = 128, HTB = HALF * BK * 2  , STAGE_BYTES = 8 * HTB, NXCD = 8, WGM = 4;

__host__ __device__ __forceinline__ int lds_byte(int r, int c) { const int st = (r >> 4) * 2 + (c >> 5), rr = r & 15, cc = c & 31, ob = rr * 64 + cc * 2; return st * 1024 + (ob ^ (((ob >> 9) & 1) << 5)); }
__host__ __device__ __forceinline__ void stage_rc(int b, int& R, int& C) { const int st = b / 1024, sb = b % 1024, swz = sb ^ (((sb >> 9) & 1) << 5); R = (st >> 1) * 16 + swz / 64; C = (st & 1) * 32 + (swz % 64) / 2; }
__host__ __device__ __forceinline__ int perm32(int rho) { const int n = rho >> 4, i = rho & 15; return 8 * (i >> 2) + 4 * n + (i & 3); }

struct Unit { int pm, pn; };
struct Gemm { const bf16_t* A; const bf16_t* Bt; int M, N, K; };

struct StaticOrder {
    int nM, nN, nwg, G, c;
    __host__ __device__ void init(int M, int N, int G_, int c_) { nM = M / BM; nN = N / BM; nwg = nM * nN; G = G_; c = c_; }
    __host__ __device__ bool next(int i, Unit& u) const {
        const long L = (long)i * G + c; if (L >= nwg) return false;
        int wgid = (int)L; { const int q = nwg / NXCD, r = nwg % NXCD, xcd = wgid % NXCD, off = wgid / NXCD; wgid = (xcd < r ? xcd * (q + 1) : r * (q + 1) + (xcd - r) * q) + off; }
        const int nig = WGM * nN, gid = wgid / nig, fm = gid * WGM, gsz = (nM - fm) < WGM ? (nM - fm) : WGM;
        u.pm = fm + ((wgid % nig) % gsz); u.pn = (wgid % nig) / gsz; return true;
    }
    __device__ __forceinline__ void a_ready(const Unit&) const {}
    __device__ __forceinline__ void done(const Unit&) const {}
};

__device__ __forceinline__ unsigned cvt_pk_bf16(float lo, float hi) { unsigned r; asm volatile("v_cvt_pk_bf16_f32 %0, %1, %2" : "=v"(r) : "v"(lo), "v"(hi)); return r; }
typedef float f32x2 __attribute__((ext_vector_type(2)));
template <class Epi, class Sched, bool ALIGN_EPI = false, bool SP2 = false>
__device__ __forceinline__ void gemm_phase(PG8_LAS unsigned char* lds, const Gemm g, const Sched& S, const Epi& E) {
    const int tid = threadIdx.x, wid = __builtin_amdgcn_readfirstlane(tid >> 6), lane = tid & 63, wr = wid >> 2, wc = wid & 3, fr = lane & 15, fq = lane >> 4;
    const int K = g.K, nt = K / BK;
    unsigned voffA[2], voffB[2];
#pragma unroll
    for (int i = 0; i < 2; ++i) { int R, C; stage_rc(tid * 16 + i * 8192, R, C); const int Rb = Epi::PERM ? ((R & ~31) + perm32(R & 31)) : R;
        voffA[i] = (unsigned)(R * K + C) * 2u; voffB[i] = (unsigned)(Rb * K + C) * 2u; }
    const size_t kstep = (size_t)(BK * 2);
    const size_t hstep = (size_t)HALF * K * 2;
    const size_t tstep = 2 * hstep;
    const unsigned ldsw = (unsigned)wid * 1024u;
    const int aoff = lds_byte(wr * 64 + fr, fq * 8), boff = lds_byte(wc * 32 + fr, fq * 8);
#define PG8_SA(b, h) (((b) * 2 + (h)) * HTB)
#define PG8_SB(b, h) ((4 + (b) * 2 + (h)) * HTB)
#define PG8_STAGE(bufoff, gbase, voff) do { _Pragma("unroll") for (int _i = 0; _i < 2; ++_i) \
        __builtin_amdgcn_global_load_lds((const unsigned*)((const char*)(gbase) + (voff)[_i]), (PG8_LAS unsigned*)(lds + (bufoff) + ldsw + _i * 8192), 16, 0, 0); } while (0)
#define PG8_LDA(dst, b, h) do { _Pragma("unroll") for (int m = 0; m < 4; ++m) _Pragma("unroll") for (int k = 0; k < 2; ++k) dst[m][k] = *(const PG8_LAS bf16x8*)(lds + PG8_SA(b, h) + aoff + m * 2048 + k * 1024); } while (0)
#define PG8_LDB(dst, b, h) do { _Pragma("unroll") for (int n = 0; n < 2; ++n) _Pragma("unroll") for (int k = 0; k < 2; ++k) dst[n][k] = *(const PG8_LAS bf16x8*)(lds + PG8_SB(b, h) + boff + n * 2048 + k * 1024); } while (0)
#define PG8_MMA(ai, bj, At, Bt) do { __builtin_amdgcn_s_setprio(1); _Pragma("unroll") for (int m = 0; m < 4; ++m) _Pragma("unroll") for (int n = 0; n < 2; ++n) _Pragma("unroll") for (int k = 0; k < 2; ++k) \
        acc[ai][bj][m][n] = __builtin_amdgcn_mfma_f32_16x16x32_bf16(Bt[n][k], At[m][k], acc[ai][bj][m][n], 0, 0, 0); __builtin_amdgcn_s_setprio(0); } while (0)
#define PG8_WAIT_V(n) asm volatile("s_waitcnt vmcnt(" #n ")" ::: "memory")
#define PG8_WAIT_L(n) asm volatile("s_waitcnt lgkmcnt(" #n ")" ::: "memory")
#define PG8_BAR __builtin_amdgcn_s_barrier()
#define PG8_SCHED __builtin_amdgcn_sched_barrier(0)
    Unit cur, nxt; int ui = 0;
    if (!S.next(0, cur)) return;
    f32x4 acc[2][2][4][2];
#pragma unroll
    for (int a = 0; a < 2; ++a)
#pragma unroll
        for (int b = 0; b < 2; ++b)
#pragma unroll
            for (int m = 0; m < 4; ++m)
#pragma unroll
                for (int n = 0; n < 2; ++n) acc[a][b][m][n] = (f32x4){0.f, 0.f, 0.f, 0.f};
    if constexpr (Epi::ACC_INIT) E.init(acc, cur, wr, wc, fr, fq);
    bf16x8 At[4][2], B0[2][2], B1[2][2];
    const char* cA = (const char*)g.A + (size_t)cur.pm * tstep; const char* cB = (const char*)g.Bt + (size_t)cur.pn * tstep;
    S.a_ready(cur);
    if constexpr (SP2) {
        PG8_STAGE(PG8_SB(0, 0), cB, voffB); PG8_STAGE(PG8_SB(0, 1), cB + hstep, voffB); PG8_STAGE(PG8_SA(0, 0), cA, voffA); PG8_STAGE(PG8_SA(0, 1), cA + hstep, voffA);
        if (wr == 1) PG8_BAR;
        PG8_WAIT_V(2); PG8_BAR;
        PG8_STAGE(PG8_SB(1, 0), cB + kstep, voffB); PG8_STAGE(PG8_SA(1, 0), cA + kstep, voffA); PG8_STAGE(PG8_SB(1, 1), cB + hstep + kstep, voffB);
        PG8_WAIT_V(6); PG8_BAR;
    } else {
        PG8_STAGE(PG8_SB(0, 0), cB, voffB); PG8_STAGE(PG8_SA(0, 0), cA, voffA); PG8_STAGE(PG8_SB(0, 1), cB + hstep, voffB); PG8_STAGE(PG8_SA(0, 1), cA + hstep, voffA);
        if (wr == 1) PG8_BAR;
        PG8_WAIT_V(4); PG8_BAR;
        PG8_STAGE(PG8_SB(1, 0), cB + kstep, voffB); PG8_STAGE(PG8_SA(1, 0), cA + kstep, voffA); PG8_STAGE(PG8_SB(1, 1), cB + hstep + kstep, voffB);
        PG8_WAIT_V(6); PG8_BAR;
    }
    for (;;) {
        const bool has_next = S.next(ui + 1, nxt);
        const char* nA = has_next ? (const char*)g.A + (size_t)nxt.pm * tstep : cA; const char* nB = has_next ? (const char*)g.Bt + (size_t)nxt.pn * tstep : cB;
        for (int t = 0; t < nt; t += 2) {
            const bool last = (t == nt - 2);
            const char* a1 = cA + (size_t)(t + 1) * kstep;
            const char* a2 = last ? nA : cA + (size_t)(t + 2) * kstep; const char* b2 = last ? nB : cB + (size_t)(t + 2) * kstep;
            const char* a3 = a2 + kstep; const char* b3 = b2 + kstep;
            if (last && has_next) S.a_ready(nxt);
            if constexpr (SP2) {
            PG8_LDB(B0, 0, 0); PG8_LDB(B1, 0, 1); PG8_SCHED; PG8_LDA(At, 0, 0); PG8_STAGE(PG8_SA(1, 1), a1 + hstep, voffA);
            PG8_WAIT_V(8); PG8_WAIT_L(0); PG8_BAR; PG8_MMA(0, 0, At, B0); PG8_MMA(0, 1, At, B1); PG8_BAR; PG8_SCHED;
            PG8_LDA(At, 0, 1); PG8_STAGE(PG8_SB(0, 0), b2, voffB); PG8_STAGE(PG8_SB(0, 1), b2 + hstep, voffB); PG8_STAGE(PG8_SA(0, 0), a2, voffA);
            PG8_WAIT_V(8); PG8_WAIT_L(0); PG8_BAR; PG8_MMA(1, 0, At, B0); PG8_MMA(1, 1, At, B1); PG8_BAR; PG8_SCHED;
            PG8_LDB(B0, 1, 0); PG8_LDB(B1, 1, 1); PG8_SCHED; PG8_LDA(At, 1, 0); PG8_STAGE(PG8_SA(0, 1), a2 + hstep, voffA);
            PG8_WAIT_V(8); PG8_WAIT_L(0); PG8_BAR; PG8_MMA(0, 0, At, B0); PG8_MMA(0, 1, At, B1); PG8_BAR; PG8_SCHED;
            PG8_LDA(At, 1, 1); PG8_STAGE(PG8_SB(1, 0), b3, voffB); PG8_STAGE(PG8_SB(1, 1), b3 + hstep, voffB); PG8_STAGE(PG8_SA(1, 0), a3, voffA);
            PG8_WAIT_V(8); PG8_WAIT_L(0); PG8_BAR; PG8_MMA(1, 0, At, B0); PG8_MMA(1, 1, At, B1); PG8_BAR; PG8_SCHED;
            } else {
            PG8_LDB(B0, 0, 0); PG8_SCHED; PG8_LDA(At, 0, 0); PG8_STAGE(PG8_SA(1, 1), a1 + hstep, voffA);
            PG8_WAIT_L(8); PG8_BAR; PG8_WAIT_L(0); PG8_MMA(0, 0, At, B0); PG8_BAR; PG8_SCHED;
            PG8_LDB(B1, 0, 1); PG8_STAGE(PG8_SB(0, 0), b2, voffB);
            PG8_BAR; PG8_WAIT_L(0); PG8_MMA(0, 1, At, B1); PG8_BAR;
            PG8_LDA(At, 0, 1); PG8_STAGE(PG8_SA(0, 0), a2, voffA);
            PG8_BAR; PG8_WAIT_L(0); PG8_MMA(1, 0, At, B0); PG8_BAR; PG8_SCHED;
            PG8_STAGE(PG8_SB(0, 1), b2 + hstep, voffB);
            PG8_WAIT_V(6); PG8_BAR; PG8_MMA(1, 1, At, B1); PG8_BAR;
            PG8_LDB(B0, 1, 0); PG8_SCHED; PG8_LDA(At, 1, 0); PG8_STAGE(PG8_SA(0, 1), a2 + hstep, voffA);
            PG8_WAIT_L(8); PG8_BAR; PG8_WAIT_L(0); PG8_MMA(0, 0, At, B0); PG8_BAR; PG8_SCHED;
            PG8_LDB(B1, 1, 1); PG8_STAGE(PG8_SB(1, 0), b3, voffB);
            PG8_BAR; PG8_WAIT_L(0); PG8_MMA(0, 1, At, B1); PG8_BAR;
            PG8_LDA(At, 1, 1); PG8_STAGE(PG8_SA(1, 0), a3, voffA);
            PG8_BAR; PG8_WAIT_L(0); PG8_MMA(1, 0, At, B0); PG8_BAR; PG8_SCHED;
            PG8_STAGE(PG8_SB(1, 1), b3 + hstep, voffB);
            PG8_WAIT_V(6); PG8_BAR; PG8_MMA(1, 1, At, B1); PG8_BAR;
            }
        }
        if constexpr (ALIGN_EPI) { if (wr == 0) PG8_BAR; }
        if constexpr (!Epi::AFTER_DRAIN) { E(acc, cur, wr, wc, fr, fq); S.done(cur); }
        if (!has_next) break;
#pragma unroll
        for (int a = 0; a < 2; ++a)
#pragma unroll
            for (int b = 0; b < 2; ++b)
#pragma unroll
                for (int m = 0; m < 4; ++m)
#pragma unroll
                    for (int n = 0; n < 2; ++n) acc[a][b][m][n] = (f32x4){0.f, 0.f, 0.f, 0.f};
        if constexpr (Epi::ACC_INIT) E.init(acc, nxt, wr, wc, fr, fq);
        cur = nxt; cA = nA; cB = nB; ++ui;
        if constexpr (ALIGN_EPI) { if (wr == 1) PG8_BAR; }
    }
    PG8_WAIT_V(0);
    if constexpr (!ALIGN_EPI) { if (wr == 0) PG8_BAR; }
    PG8_BAR;
    if constexpr (Epi::AFTER_DRAIN) { E.fused(acc, cur, wr, wc, fr, fq, lds, wid, lane); S.done(cur); }
#undef PG8_SA
#undef PG8_SB
#undef PG8_STAGE
#undef PG8_LDA
#undef PG8_LDB
#undef PG8_MMA
#undef PG8_WAIT_V
#undef PG8_WAIT_L
#undef PG8_BAR
#undef PG8_SCHED
}
}

constexpr int DM = 2048, MP = 8192, MS = 512, MT = MP + MS, SEQ = 2048, TS = 16, PAST = 1024, NH = 8, HD = 128;
constexpr int N1 = 8192, LDW0 = 8200, N3 = 12288, CW = 4096, NG = 16, GD = 256, CCH = 128;
constexpr float RMS_EPS = 1e-6f, LN_EPS = 1e-5f, LOG2E = 1.4426950408889634f;
constexpr float QSCALE = 0.08838834764831845f * 1.4426950408889634f;
constexpr size_t O_YP = 0, O_YS = O_YP + (size_t)MP * DM, O_FKP = O_YS + (size_t)MS * DM, O_FVP = O_FKP + (size_t)MP * 1024, O_FLP = O_FVP + (size_t)MP * 1024,
    O_FKS = O_FLP + (size_t)MP * 8, O_FVS = O_FKS + (size_t)MS * 1024, O_FLS = O_FVS + (size_t)MS * 1024, O_SKP = O_FLS + (size_t)MS * 8, O_SVP = O_SKP + (size_t)MP * 1024,
    O_SKS = O_SVP + (size_t)MP * 1024, O_SVS = O_SKS + (size_t)MS * 1024, O_SGV = O_SVS + (size_t)MS * 1024, O_END = O_SGV + (size_t)MS * CW;
constexpr size_t MiB = 1u << 20;
constexpr size_t WS_STAT = 0, WS_W0T = 1 * MiB, WS_WO0T = 33 * MiB, WS_W1T = 41 * MiB, WS_WO1T = 89 * MiB, WS_XN = 105 * MiB, WS_P1 = 139 * MiB, WS_MIX = 275 * MiB,
    WS_UVZ = 105 * MiB  , WS_H1 = 309 * MiB, WS_A1 = 377 * MiB, WS_ACT = 411 * MiB, WS_SCR = 479 * MiB  , WS_BAR = 495 * MiB  , WS_END = 496 * MiB;
constexpr int ST_SSQ1 = 0, ST_VSUM = 16384, ST_VSQ = 32768, ST_SSQ2 = 49152, ST_CNT2 = 60000, ST_CNT4 = 61000;
constexpr int LDS_BYTES = 131072 + 16384;

typedef unsigned short bf16_t;
typedef short bf16x8 __attribute__((ext_vector_type(8)));
typedef short s16x4 __attribute__((ext_vector_type(4)));
typedef float f32x4 __attribute__((ext_vector_type(4)));
typedef float f32x8 __attribute__((ext_vector_type(8)));
typedef float f32x16 __attribute__((ext_vector_type(16)));
typedef unsigned u32x4 __attribute__((ext_vector_type(4)));
typedef unsigned u32x2 __attribute__((ext_vector_type(2)));
#define LAS __attribute__((address_space(3)))
#define SBAR() __builtin_amdgcn_sched_barrier(0)

struct Params {
    const float *x_prompt, *x_sample, *cfk, *cfv, *cflogf, *csk, *csv, *norm0_g, *w_in0, *b_forget, *w_out0, *norm1_g, *w_in1, *ln_g, *ln_b, *w_sp, *b_sp, *w_out1, *final_g;
    float* out; unsigned char* ws; int ph_lo, ph_hi;
};

__device__ __forceinline__ unsigned cvtpk(float lo, float hi) { unsigned r; asm volatile("v_cvt_pk_bf16_f32 %0, %1, %2" : "=v"(r) : "v"(lo), "v"(hi)); return r; }
__device__ __forceinline__ float wave_sum(float v) {
#pragma unroll
    for (int o = 1; o < 64; o <<= 1) v += __shfl_xor(v, o);
    return v;
}
__device__ __forceinline__ float bf2f(short s) { return __uint_as_float(((unsigned)(unsigned short)s) << 16); }
__device__ __forceinline__ float silu_f(float g) { return g / (1.f + __expf(-g)); }

using pg8::Unit;
#define EPI_TILE_OP() __device__ __forceinline__ void operator()(const f32x4 (&acc)[2][2][4][2], const Unit& u, int wr, int wc, int fr, int fq) const { \
    _Pragma("unroll") for (int ai = 0; ai < 2; ++ai) _Pragma("unroll") for (int bj = 0; bj < 2; ++bj) quad(acc[ai][bj], u.pm * 256 + ai * 128, u.pn * 256 + bj * 128, wr, wc, fr, fq); }
__device__ __forceinline__ float silu_fast(float g) { return g * __builtin_amdgcn_rcpf(1.f + __builtin_amdgcn_exp2f(-g * LOG2E)); }
struct Epi1 {
    static constexpr bool PERM = true, AFTER_DRAIN = false, ACC_INIT = false;
    bf16_t* P1; float* out;
    __device__ __forceinline__ void quad(const f32x4 (&a)[4][2], int rowq, int colq, int wr, int wc, int fr, int fq) const {
        const int seg = colq >> 10; const bool samp = rowq >= MP;
        const float sc = (seg == 0 || seg == 4) ? QSCALE : 1.f;
        float* fdst = nullptr;
        if (seg == 1) fdst = out + (samp ? O_FKS : O_FKP); else if (seg == 2) fdst = out + (samp ? O_FVS : O_FVP);
        else if (seg == 5) fdst = out + (samp ? O_SKS : O_SKP); else if (seg == 6) fdst = out + (samp ? O_SVS : O_SVP);
        const int row0 = rowq + wr * 64 + fr, col0 = colq + wc * 32 + 8 * fq, lro = samp ? MP : 0;
#pragma unroll
        for (int m = 0; m < 4; ++m) { const int row = row0 + m * 16; const f32x4 v0 = a[m][0], v1 = a[m][1];
            u32x4 w; w.x = cvtpk(v0[0] * sc, v0[1] * sc); w.y = cvtpk(v0[2] * sc, v0[3] * sc); w.z = cvtpk(v1[0] * sc, v1[1] * sc); w.w = cvtpk(v1[2] * sc, v1[3] * sc);
            *(u32x4*)(P1 + ((size_t)(col0 >> 7) * MT + row) * 128 + (col0 & 127)) = w;
            if (fdst) { float* d = fdst + (size_t)(row - lro) * 1024 + (col0 & 1023); __builtin_nontemporal_store(v0, (f32x4*)d); __builtin_nontemporal_store(v1, (f32x4*)(d + 4)); } }
    }
    EPI_TILE_OP()
};
struct Epi2 {
    static constexpr bool PERM = false, AFTER_DRAIN = false, ACC_INIT = true;
    const float *xp, *xs, *g1; float* H1; bf16_t* A1; float* ssq; bool pre;
    __device__ __forceinline__ void init(f32x4 (&acc)[2][2][4][2], const Unit& u, int wr, int wc, int fr, int fq) const {
#pragma unroll
        for (int ai = 0; ai < 2; ++ai)
#pragma unroll
            for (int m = 0; m < 4; ++m) { const int row = u.pm * 256 + ai * 128 + wr * 64 + m * 16 + fr; const float* xr = row < MP ? xp + (size_t)row * DM : xs + (size_t)(row - MP) * DM;
#pragma unroll
                for (int bj = 0; bj < 2; ++bj)
#pragma unroll
                    for (int n = 0; n < 2; ++n) acc[ai][bj][m][n] = __builtin_nontemporal_load((const f32x4*)(xr + u.pn * 256 + bj * 128 + wc * 32 + 4 * fq + n * 16)); }
    }
    __device__ __forceinline__ void quad(const f32x4 (&a)[4][2], int rowq, int colq, int wr, int wc, int fr, int fq) const {
        const int col0 = colq + wc * 32 + 4 * fq;
#pragma unroll
        for (int m = 0; m < 4; ++m) { const int row = rowq + wr * 64 + m * 16 + fr;
            const float* xr = row < MP ? xp + (size_t)row * DM : xs + (size_t)(row - MP) * DM; float s = 0.f;
#pragma unroll
            for (int n = 0; n < 2; ++n) { const int c = col0 + n * 16; f32x4 hv = a[m][n]; if (!pre) hv += *(const f32x4*)(xr + c);
                __builtin_nontemporal_store(hv, (f32x4*)(H1 + (size_t)row * DM + c)); s += (hv[0] * hv[0] + hv[1] * hv[1]) + (hv[2] * hv[2] + hv[3] * hv[3]);
                const f32x4 gv = *(const f32x4*)(g1 + c); u32x2 w; w.x = cvtpk(hv[0] * gv[0], hv[1] * gv[1]); w.y = cvtpk(hv[2] * gv[2], hv[3] * gv[3]);
                *(u32x2*)(A1 + (size_t)row * DM + c) = w; }
            s += __shfl_xor(s, 16); s += __shfl_xor(s, 32);
            if (fq == 0) unsafeAtomicAdd(ssq + row, s); }
    }
    EPI_TILE_OP()
};
struct Epi3 {
    static constexpr bool PERM = true, AFTER_DRAIN = false, ACC_INIT = false;
    const float* ssq1; bf16_t* UZV; float *vsum, *vsq;
    __device__ __forceinline__ void quad(const f32x4 (&a)[4][2], int rowq, int colq, int wr, int wc, int fr, int fq) const {
        const int row0 = rowq + wr * 64 + fr, col0 = colq + wc * 32 + 8 * fq;
        if (colq < 2 * CW) {
#pragma unroll
            for (int m = 0; m < 4; ++m) { const int row = row0 + m * 16; const float rs = rsqrtf(ssq1[row] * (1.f / DM) + RMS_EPS);
                const f32x4 uu = a[m][0] * rs, zz = a[m][1] * rs; u32x2 w;
                w.x = cvtpk(uu[0] * silu_fast(zz[0]), uu[1] * silu_fast(zz[1])); w.y = cvtpk(uu[2] * silu_fast(zz[2]), uu[3] * silu_fast(zz[3]));
                const int cu = col0 >> 1; *(u32x2*)(UZV + ((size_t)(cu >> 8) * MT + row) * 256 + (cu & 255)) = w; }
        } else {
#pragma unroll
            for (int m = 0; m < 4; ++m) { const int row = row0 + m * 16; const float rs = rsqrtf(ssq1[row] * (1.f / DM) + RMS_EPS);
                const f32x4 v0 = a[m][0] * rs, v1 = a[m][1] * rs;
                u32x4 w; w.x = cvtpk(v0[0], v0[1]); w.y = cvtpk(v0[2], v0[3]); w.z = cvtpk(v1[0], v1[1]); w.w = cvtpk(v1[2], v1[3]);
                const int cv = col0 - 2 * CW; *(u32x4*)(UZV + (size_t)MT * CW + ((size_t)(cv >> 8) * MT + row) * 256 + (cv & 255)) = w;
                float s = ((v0[0] + v0[1]) + (v0[2] + v0[3])) + ((v1[0] + v1[1]) + (v1[2] + v1[3]));
                float q = ((v0[0] * v0[0] + v0[1] * v0[1]) + (v0[2] * v0[2] + v0[3] * v0[3])) + ((v1[0] * v1[0] + v1[1] * v1[1]) + (v1[2] * v1[2] + v1[3] * v1[3]));
                s += __shfl_xor(s, 16); s += __shfl_xor(s, 32); q += __shfl_xor(q, 16); q += __shfl_xor(q, 32);
                if (fq == 0) { unsafeAtomicAdd(vsum + row, s); unsafeAtomicAdd(vsq + row, q); } }
        }
    }
    __device__ __forceinline__ void operator()(const f32x4 (&acc)[2][2][4][2], const Unit& u, int wr, int wc, int fr, int fq) const {
        if (u.pn * 256 < 2 * CW) {
#pragma unroll
            for (int ai = 0; ai < 2; ++ai)
#pragma unroll
                for (int bj = 0; bj < 2; ++bj) quad(acc[ai][bj], u.pm * 256 + ai * 128, u.pn * 256 + bj * 128, wr, wc, fr, fq);
        } else {
#pragma unroll
            for (int ai = 0; ai < 2; ++ai)
#pragma unroll
                for (int m = 0; m < 4; ++m) { const int row = u.pm * 256 + ai * 128 + wr * 64 + fr + m * 16; const float rs = rsqrtf(ssq1[row] * (1.f / DM) + RMS_EPS); float s = 0.f, q = 0.f;
#pragma unroll
                    for (int bj = 0; bj < 2; ++bj) { const int cv = u.pn * 256 + bj * 128 + wc * 32 + 8 * fq - 2 * CW; const f32x4 v0 = acc[ai][bj][m][0] * rs, v1 = acc[ai][bj][m][1] * rs;
                        u32x4 w; w.x = cvtpk(v0[0], v0[1]); w.y = cvtpk(v0[2], v0[3]); w.z = cvtpk(v1[0], v1[1]); w.w = cvtpk(v1[2], v1[3]);
                        *(u32x4*)(UZV + (size_t)MT * CW + ((size_t)(cv >> 8) * MT + row) * 256 + (cv & 255)) = w;
                        s += ((v0[0] + v0[1]) + (v0[2] + v0[3])) + ((v1[0] + v1[1]) + (v1[2] + v1[3]));
                        q += ((v0[0] * v0[0] + v0[1] * v0[1]) + (v0[2] * v0[2] + v0[3] * v0[3])) + ((v1[0] * v1[0] + v1[1] * v1[1]) + (v1[2] * v1[2] + v1[3] * v1[3])); }
                    s += __shfl_xor(s, 16); s += __shfl_xor(s, 32); q += __shfl_xor(q, 16); q += __shfl_xor(q, 32);
                    if (fq == 0) { unsafeAtomicAdd(vsum + row, s); unsafeAtomicAdd(vsq + row, q); } }
        }
    }
};
struct Epi4 {
    static constexpr bool PERM = false, AFTER_DRAIN = false, ACC_INIT = true;
    const float* H1; float* out; float* ssq; bool pre;
    __device__ __forceinline__ void init(f32x4 (&acc)[2][2][4][2], const Unit& u, int wr, int wc, int fr, int fq) const {
#pragma unroll
        for (int ai = 0; ai < 2; ++ai)
#pragma unroll
            for (int m = 0; m < 4; ++m) { const int row = u.pm * 256 + ai * 128 + wr * 64 + m * 16 + fr;
#pragma unroll
                for (int bj = 0; bj < 2; ++bj)
#pragma unroll
                    for (int n = 0; n < 2; ++n) acc[ai][bj][m][n] = __builtin_nontemporal_load((const f32x4*)(H1 + (size_t)row * DM + u.pn * 256 + bj * 128 + wc * 32 + 4 * fq + n * 16)); }
    }
    __device__ __forceinline__ void quad(const f32x4 (&a)[4][2], int rowq, int colq, int wr, int wc, int fr, int fq) const {
        const int col0 = colq + wc * 32 + 4 * fq;
#pragma unroll
        for (int m = 0; m < 4; ++m) { const int row = rowq + wr * 64 + m * 16 + fr; float s = 0.f;
#pragma unroll
            for (int n = 0; n < 2; ++n) { const int c = col0 + n * 16; f32x4 hv = a[m][n]; if (!pre) hv += *(const f32x4*)(H1 + (size_t)row * DM + c);
                *(f32x4*)(out + (size_t)row * DM + c) = hv; s += (hv[0] * hv[0] + hv[1] * hv[1]) + (hv[2] * hv[2] + hv[3] * hv[3]); }
            s += __shfl_xor(s, 16); s += __shfl_xor(s, 32);
            if (fq == 0) unsafeAtomicAdd(ssq + row, s); }
    }
    EPI_TILE_OP()
};

template <class Epi, int KS = 1>
__device__ __forceinline__ void gemm_small_phase(PG8_LAS unsigned char* lds, const bf16_t* A, const bf16_t* Bt, int row_off, int Ms, int N, int K, const Epi& E, float* scr = nullptr, unsigned* cnt = nullptr) {
    const int tid = threadIdx.x, wid = __builtin_amdgcn_readfirstlane(tid >> 6), lane = tid & 63, wr = wid >> 2, wc = wid & 3, fr = lane & 15, fq = lane >> 4;
    unsigned voffA[2], voffB[2];
#pragma unroll
    for (int i = 0; i < 2; ++i) { int R, C; pg8::stage_rc(tid * 16 + i * 8192, R, C); const int Rb = Epi::PERM ? ((R & ~31) + pg8::perm32(R & 31)) : R;
        voffA[i] = (unsigned)(R * K + C) * 2u; voffB[i] = (unsigned)(Rb * K + C) * 2u; }
    const unsigned ldsw = (unsigned)wid * 1024u;
    const int aoff = pg8::lds_byte(wr * 64 + fr, fq * 8), boff = pg8::lds_byte(wc * 32 + fr, fq * 8);
    const int nMq = Ms / 128, nu = nMq * (N / 128), nt = K / 64 / KS;
#define GS_STAGE(slot, ga, gb) do { _Pragma("unroll") for (int _i = 0; _i < 2; ++_i) { \
        __builtin_amdgcn_global_load_lds((const unsigned*)((ga) + voffA[_i]), (PG8_LAS unsigned*)(lds + (slot) * 32768 + ldsw + _i * 8192), 16, 0, 0); \
        __builtin_amdgcn_global_load_lds((const unsigned*)((gb) + voffB[_i]), (PG8_LAS unsigned*)(lds + (slot) * 32768 + 16384 + ldsw + _i * 8192), 16, 0, 0); } } while (0)
    const int nNq = N / 128, xcd = blockIdx.x & 7, per = gridDim.x >> 3; (void)nu;
    if ((int)(blockIdx.x >> 3) < per)
    for (int loc = blockIdx.x >> 3; ; loc += per) {
        const int split = loc % KS, ul = loc / KS; const int pm = ul % nMq, pn = (ul / nMq) * 8 + xcd; if (pn >= nNq) break;
        const char* cA = (const char*)A + ((size_t)(row_off + pm * 128) * K + (size_t)split * (K / KS)) * 2; const char* cB = (const char*)Bt + ((size_t)(pn * 128) * K + (size_t)split * (K / KS)) * 2;
        f32x4 acc[4][2];
#pragma unroll
        for (int m = 0; m < 4; ++m) { acc[m][0] = (f32x4){0.f, 0.f, 0.f, 0.f}; acc[m][1] = (f32x4){0.f, 0.f, 0.f, 0.f}; }
        GS_STAGE(0, cA, cB); GS_STAGE(1, cA + 128, cB + 128); GS_STAGE(2, cA + 256, cB + 256);
        for (int t = 0; t < nt; ++t) {
            asm volatile("s_waitcnt vmcnt(8)" ::: "memory"); __builtin_amdgcn_s_barrier();
            { const int tn = (t + 3 < nt) ? t + 3 : t + 3 - nt; GS_STAGE((t + 3) & 3, cA + (size_t)tn * 128, cB + (size_t)tn * 128); }
            const int so = (t & 3) * 32768;
            bf16x8 At[4][2], Bf[2][2];
#pragma unroll
            for (int m = 0; m < 4; ++m)
#pragma unroll
                for (int k = 0; k < 2; ++k) At[m][k] = *(const PG8_LAS bf16x8*)(lds + so + aoff + m * 2048 + k * 1024);
#pragma unroll
            for (int n = 0; n < 2; ++n)
#pragma unroll
                for (int k = 0; k < 2; ++k) Bf[n][k] = *(const PG8_LAS bf16x8*)(lds + so + 16384 + boff + n * 2048 + k * 1024);
            asm volatile("s_waitcnt lgkmcnt(0)" ::: "memory"); __builtin_amdgcn_sched_barrier(0);
#pragma unroll
            for (int m = 0; m < 4; ++m)
#pragma unroll
                for (int n = 0; n < 2; ++n)
#pragma unroll
                    for (int k = 0; k < 2; ++k) acc[m][n] = __builtin_amdgcn_mfma_f32_16x16x32_bf16(Bf[n][k], At[m][k], acc[m][n], 0, 0, 0);
        }
        asm volatile("s_waitcnt vmcnt(0)" ::: "memory"); __builtin_amdgcn_s_barrier();
        if (KS > 1) {
            typedef unsigned long long u64;
            const int unit = pn * nMq + pm; u64* part = (u64*)scr + (size_t)unit * KS * 16 * 512 + tid;
#pragma unroll
            for (int j = 0; j < 16; ++j) { const f32x4 v = acc[j >> 2][(j >> 1) & 1]; const float lo = (j & 1) ? v[2] : v[0], hi2 = (j & 1) ? v[3] : v[1];
                __hip_atomic_store(part + (size_t)(split * 16 + j) * 512, ((u64)__float_as_uint(hi2) << 32) | (u64)__float_as_uint(lo), __ATOMIC_RELAXED, __HIP_MEMORY_SCOPE_AGENT); }
            asm volatile("s_waitcnt vmcnt(0)" ::: "memory"); __syncthreads();
            if (tid == 0) { const unsigned old = __hip_atomic_fetch_add(cnt + unit, 1u, __ATOMIC_RELAXED, __HIP_MEMORY_SCOPE_AGENT); *(PG8_LAS unsigned*)(lds + 131072) = old; }
            __syncthreads();
            const bool last = *(PG8_LAS unsigned*)(lds + 131072) == (unsigned)(KS - 1);
            __syncthreads();
            if (!last) continue;
            __builtin_amdgcn_fence(__ATOMIC_ACQUIRE, "agent");
#pragma unroll
            for (int j = 0; j < 16; ++j) { float lo = 0.f, hi2 = 0.f;
#pragma unroll
                for (int sp = 0; sp < KS; ++sp) { const u64 w = *(const u64*)(part + (size_t)(sp * 16 + j) * 512); lo += __uint_as_float((unsigned)w); hi2 += __uint_as_float((unsigned)(w >> 32)); }
                f32x4& v = acc[j >> 2][(j >> 1) & 1]; if (j & 1) { v[2] = lo; v[3] = hi2; } else { v[0] = lo; v[1] = hi2; } }
        }
        E.quad(acc, row_off + pm * 128, pn * 128, wr, wc, fr, fq);
    }
#undef GS_STAGE
}

#define KSWZ(row, colB) ((row) * 256 + ((colB) ^ (((row) & 7) << 4)))
__device__ __forceinline__ int crow(int r, int hi) { return (r & 3) + 8 * (r >> 2) + 4 * hi; }
__device__ __forceinline__ bf16x8 tobf8(f32x8 x) { u32x4 w = {cvtpk(x[0], x[1]), cvtpk(x[2], x[3]), cvtpk(x[4], x[5]), cvtpk(x[6], x[7])}; return *reinterpret_cast<bf16x8*>(&w); }
__device__ __forceinline__ f32x8 tof8(bf16x8 x) { f32x8 r;
#pragma unroll
    for (int i = 0; i < 8; ++i) r[i] = bf2f(x[i]); return r; }
__device__ __forceinline__ void qkt(f32x16& p0, f32x16& p1, const char* Ks, const char* Qs, int r32, int hi) {
#pragma unroll
    for (int d0 = 0; d0 < 8; ++d0) { const int cb = (d0 * 16 + hi * 8) * 2;
        const bf16x8 qv = *reinterpret_cast<const bf16x8*>(Qs + KSWZ(r32, cb));
        const bf16x8 b0 = *reinterpret_cast<const bf16x8*>(Ks + KSWZ(r32, cb));
        const bf16x8 b1 = *reinterpret_cast<const bf16x8*>(Ks + KSWZ(32 + r32, cb));
        p0 = __builtin_amdgcn_mfma_f32_32x32x16_bf16(b0, qv, p0, 0, 0, 0);
        p1 = __builtin_amdgcn_mfma_f32_32x32x16_bf16(b1, qv, p1, 0, 0, 0); }
}
__device__ __forceinline__ int v_st(int k, int c) { const int kk = (k & ~0xC) | ((k & 4) << 1) | ((k & 8) >> 1); return ((kk >> 3) * 4 + (c >> 5)) * 512 + ((kk & 7) * 32 + (c & 31)) * 2; }
__device__ __forceinline__ int v_rd_base(int lane) { return ((lane & 3) << 3) | (((lane >> 2) & 3) << 6) | (((lane >> 4) & 1) << 5) | (((lane >> 5) & 1) << 8); }
constexpr int v_rd_off(int d0, int ks, int half) { return d0 * 512 + ks * 4096 + half * 2048; }
template <int OFF> __device__ __forceinline__ s16x4 tr_read(int vb) { s16x4 r; asm volatile("ds_read_b64_tr_b16 %0, %1 offset:%2" : "=&v"(r) : "v"(vb), "i"(OFF) : "memory"); return r; }
template <int D0> __device__ __forceinline__ void pv_one(f32x16& od, int vb, bf16x8 pa0, bf16x8 pa1, bf16x8 pa2, bf16x8 pa3) {
    const s16x4 l0 = tr_read<v_rd_off(D0, 0, 0)>(vb), h0 = tr_read<v_rd_off(D0, 0, 1)>(vb), l1 = tr_read<v_rd_off(D0, 1, 0)>(vb), h1 = tr_read<v_rd_off(D0, 1, 1)>(vb);
    const s16x4 l2 = tr_read<v_rd_off(D0, 2, 0)>(vb), h2 = tr_read<v_rd_off(D0, 2, 1)>(vb), l3 = tr_read<v_rd_off(D0, 3, 0)>(vb), h3 = tr_read<v_rd_off(D0, 3, 1)>(vb);
    asm volatile("s_waitcnt lgkmcnt(0)" ::: "memory"); SBAR();
#define PKV(L, H) (bf16x8){L[0], L[1], L[2], L[3], H[0], H[1], H[2], H[3]}
    od = __builtin_amdgcn_mfma_f32_32x32x16_bf16(pa0, PKV(l0, h0), od, 0, 0, 0);
    od = __builtin_amdgcn_mfma_f32_32x32x16_bf16(pa1, PKV(l1, h1), od, 0, 0, 0);
    od = __builtin_amdgcn_mfma_f32_32x32x16_bf16(pa2, PKV(l2, h2), od, 0, 0, 0);
    od = __builtin_amdgcn_mfma_f32_32x32x16_bf16(pa3, PKV(l3, h3), od, 0, 0, 0);
#undef PKV
}
__device__ __forceinline__ void pv_d0(f32x16* o, int vb, bf16x8 pa0, bf16x8 pa1, bf16x8 pa2, bf16x8 pa3) {
    pv_one<0>(o[0], vb, pa0, pa1, pa2, pa3); pv_one<1>(o[1], vb, pa0, pa1, pa2, pa3); pv_one<2>(o[2], vb, pa0, pa1, pa2, pa3); pv_one<3>(o[3], vb, pa0, pa1, pa2, pa3);
}
#define PK4(P, BASE, OUT) do { unsigned a0_ = cvtpk(P[BASE + 0], P[BASE + 1]), a1_ = cvtpk(P[BASE + 2], P[BASE + 3]);   \
    unsigned b0_ = cvtpk(P[BASE + 4], P[BASE + 5]), b1_ = cvtpk(P[BASE + 6], P[BASE + 7]);                              \
    auto r0_ = __builtin_amdgcn_permlane32_swap(a0_, b0_, false, false); auto r1_ = __builtin_amdgcn_permlane32_swap(a1_, b1_, false, false); \
    u32x4 w_ = {r0_[0], r1_[0], r0_[1], r1_[1]}; OUT = *reinterpret_cast<bf16x8*>(&w_); } while (0)

constexpr int NSP = 2;
constexpr int AL_K = 0, AL_V = 32768, AL_BIAS = 65536, AL_WS = 73728, AL_SCAN = 75776, AL_Q = 77824;

template <int MODE, bool SAMPLE>
__device__ __forceinline__ void attn_unit(const Params& p, char* lds, int b, int h, int qb) {
    constexpr int var = 0;
    const int tid = threadIdx.x, wid = __builtin_amdgcn_readfirstlane(tid >> 6), lane = tid & 63, r32 = lane & 31, hi = lane >> 5;
    char* K_lds = lds + AL_K; char* V_lds = lds + AL_V; float* biasL = (float*)(lds + AL_BIAS); float* wsc = (float*)(lds + AL_WS) + wid * 64; float* scanL = (float*)(lds + AL_SCAN);
    const bf16_t* P1 = (const bf16_t*)(p.ws + WS_P1);
    const size_t HB = (size_t)MT * 128;
    const bf16_t* P1q = P1 + (size_t)((MODE ? 32 : 0) + h) * HB;
    const size_t qrow = SAMPLE ? (size_t)(MP + b * TS + (r32 & 15)) : (size_t)(b * SEQ + qb * 256 + wid * 32 + r32);
    const bf16_t* Qw = P1q + qrow * 128 + hi * 8;
    char* Qs = lds + AL_Q + wid * 8192;
#pragma unroll
    for (int d0 = 0; d0 < 8; ++d0) *reinterpret_cast<bf16x8*>(Qs + KSWZ(r32, (d0 * 16 + hi * 8) * 2)) = *reinterpret_cast<const bf16x8*>(Qw + d0 * 16);
    const int qw0 = SAMPLE ? PAST : qb * 256 + wid * 32;
    const int qpos = SAMPLE ? PAST + (r32 & 15) : qw0 + r32;
    const int jd = SAMPLE ? 16 : (qw0 >> 6);
    const int jfirst = SAMPLE ? 16 : qb * 4 + 3;
    const bool wact = SAMPLE ? (wid == 0) : true;
    const int sr = tid >> 4, sc = (tid & 15) * 8;
    const int vst0 = v_st(sr, sc), vst1 = v_st(32 + sr, sc), kst0 = KSWZ(sr, sc * 2), kst1 = KSWZ(32 + sr, sc * 2);
    const int vb0 = (int)(uintptr_t)V_lds + v_rd_base(lane);
    struct StgT { bf16x8 k0, k1, v0, v1; f32x8 fk0, fk1, fv0, fv1; } stg2[SAMPLE ? 1 : NSP];
    const float* cK = MODE ? p.csk : p.cfk; const float* cV = MODE ? p.csv : p.cfv;
#define LOADT(j, S_) do { if (!SAMPLE) { const bf16_t* kb_ = P1q + 8 * HB + (size_t)(b * SEQ + (j) * 64) * 128 + sc;                               \
        S_.k0 = *(const bf16x8*)(kb_ + (size_t)sr * 128); S_.k1 = *(const bf16x8*)(kb_ + (size_t)(sr + 32) * 128);                                       \
        S_.v0 = *(const bf16x8*)(kb_ + 8 * HB + (size_t)sr * 128); S_.v1 = *(const bf16x8*)(kb_ + 8 * HB + (size_t)(sr + 32) * 128); }                       \
    else if ((j) < 16) { const size_t o_ = (((size_t)b * PAST + (j) * 64) * NH + h) * HD + sc;                                                        \
        S_.fk0 = __builtin_nontemporal_load((const f32x8*)(cK + o_ + (size_t)sr * 1024)); S_.fk1 = __builtin_nontemporal_load((const f32x8*)(cK + o_ + (size_t)(sr + 32) * 1024));   \
        S_.fv0 = __builtin_nontemporal_load((const f32x8*)(cV + o_ + (size_t)sr * 1024)); S_.fv1 = __builtin_nontemporal_load((const f32x8*)(cV + o_ + (size_t)(sr + 32) * 1024)); }   \
    else { const bf16_t* kb_ = P1q + 8 * HB + (size_t)(MP + b * TS) * 128 + sc; const int ra_ = sr < 15 ? sr : 15;                                   \
        S_.fk0 = tof8(*(const bf16x8*)(kb_ + (size_t)ra_ * 128)); S_.fk1 = tof8(*(const bf16x8*)(kb_ + (size_t)15 * 128));                               \
        S_.fv0 = tof8(*(const bf16x8*)(kb_ + 8 * HB + (size_t)ra_ * 128)); S_.fv1 = tof8(*(const bf16x8*)(kb_ + 8 * HB + (size_t)15 * 128)); } } while (0)
#define WRITET(buf, S_) do { if (!SAMPLE) { *(bf16x8*)(K_lds + (buf) * 16384 + kst0) = S_.k0; *(bf16x8*)(K_lds + (buf) * 16384 + kst1) = S_.k1;       \
        *(bf16x8*)(V_lds + (buf) * 16384 + vst0) = S_.v0; *(bf16x8*)(V_lds + (buf) * 16384 + vst1) = S_.v1; }                                          \
    else { *(bf16x8*)(K_lds + (buf) * 16384 + kst0) = tobf8(S_.fk0); *(bf16x8*)(K_lds + (buf) * 16384 + kst1) = tobf8(S_.fk1);                         \
        *(bf16x8*)(V_lds + (buf) * 16384 + vst0) = tobf8(S_.fv0); *(bf16x8*)(V_lds + (buf) * 16384 + vst1) = tobf8(S_.fv1); } } while (0)
    f32x16 o[4] = {};
    float m_reg = -1e30f, l_reg = 0.f, carry = 1.f;
    constexpr int NS = SAMPLE ? 1 : NSP;
    constexpr int PAR0 = SAMPLE ? 0 : 1;
    LOADT(jfirst, stg2[NS == 2 ? PAR0 : 0]); if (NS == 2) LOADT(jfirst - 1, stg2[NS == 2 ? (PAR0 ^ 1) : 0]);
    if (MODE == 0) {
        float v[4];
#pragma unroll
        for (int i = 0; i < 4; ++i) { const int pos = 4 * tid + i; float x = 0.f;
            if (SAMPLE) { if (pos < PAST) x = p.cflogf[((size_t)b * PAST + pos) * NH + h]; else if (pos < PAST + TS) x = p.out[O_FLS + ((size_t)b * TS + pos - PAST) * NH + h]; }
            else { if (pos < 256 * (qb + 1)) x = p.out[O_FLP + ((size_t)b * SEQ + pos) * NH + h]; }
            v[i] = x; }
        const float s0 = v[0], s1 = s0 + v[1], s2 = s1 + v[2], s3 = s2 + v[3]; float incl = s3;
#pragma unroll
        for (int o = 1; o < 64; o <<= 1) { const float t = __shfl_up(incl, o); if (lane >= o) incl += t; }
        if (lane == 63) scanL[wid] = incl;
        __syncthreads();
        float base = incl - s3;
#pragma unroll
        for (int w = 0; w < 8; ++w) if (w < wid) base += scanL[w];
        f32x4 bv = {-(base + s0) * LOG2E, -(base + s1) * LOG2E, -(base + s2) * LOG2E, -(base + s3) * LOG2E};
        *(f32x4*)(biasL + 4 * tid) = bv;
        __syncthreads();
    }
    for (int jj = jfirst >> 1; jj >= 0; --jj) {
#pragma unroll
      for (int par = 1; par >= 0; --par) {
        const int j = 2 * jj + par;
        if (j > jfirst) continue;
        const int buf = par;
        WRITET(buf, stg2[NS == 2 ? par : 0]);
        if (j >= NS) LOADT(j - NS, stg2[NS == 2 ? par : 0]);
        __syncthreads();
        if (wact && j <= jd && var < 2) {
            const char* Kt = K_lds + buf * 16384; const int vb = vb0 + buf * 16384;
            f32x16 p0, p1; bf16x8 pa0, pa1, pa2, pa3;
            if (MODE == 0) {
                const float* bt = biasL + j * 64 + 4 * hi;
#pragma unroll
                for (int g = 0; g < 4; ++g) { const f32x4 a = *(const f32x4*)(bt + 8 * g), c = *(const f32x4*)(bt + 32 + 8 * g);
#pragma unroll
                    for (int i = 0; i < 4; ++i) { p0[4 * g + i] = a[i]; p1[4 * g + i] = c[i]; } }
                qkt(p0, p1, Kt, Qs, r32, hi);
                if (j == jd) {
#pragma unroll
                    for (int r = 0; r < 16; ++r) { const int kp = j * 64 + crow(r, hi); if (kp > qpos) p0[r] = -1e30f; if (kp + 32 > qpos) p1[r] = -1e30f; } }
                float pmax = p0[0];
#pragma unroll
                for (int r = 1; r < 16; ++r) pmax = fmaxf(pmax, p0[r]);
#pragma unroll
                for (int r = 0; r < 16; ++r) pmax = fmaxf(pmax, p1[r]);
                { auto rr = __builtin_amdgcn_permlane32_swap(__float_as_uint(pmax), __float_as_uint(pmax), false, false); pmax = fmaxf(__uint_as_float(rr[0]), __uint_as_float(rr[1])); }
                float alpha = 1.f;
                if (!__all(pmax - m_reg <= 8.f)) { const float mn = fmaxf(m_reg, pmax); alpha = __builtin_amdgcn_exp2f(m_reg - mn); m_reg = mn; }
                float ps = 0.f;
#pragma unroll
                for (int r = 0; r < 16; ++r) { p0[r] = __builtin_amdgcn_exp2f(p0[r] - m_reg); p1[r] = __builtin_amdgcn_exp2f(p1[r] - m_reg); ps += p0[r] + p1[r]; }
                { auto rr = __builtin_amdgcn_permlane32_swap(__float_as_uint(ps), __float_as_uint(ps), false, false); ps = __uint_as_float(rr[0]) + __uint_as_float(rr[1]); }
                l_reg = l_reg * alpha + ps;
                if (__any(alpha < 1.f)) { if (hi == 0) wsc[r32] = alpha; asm volatile("s_waitcnt lgkmcnt(0)" ::: "memory");
#pragma unroll
                    for (int d = 0; d < 4; ++d)
#pragma unroll
                        for (int r = 0; r < 16; ++r) o[d][r] *= wsc[crow(r, hi)]; }
            } else {
                p0 = f32x16{}; p1 = f32x16{};
                qkt(p0, p1, Kt, Qs, r32, hi);
                if (j == jd) {
#pragma unroll
                    for (int r = 0; r < 16; ++r) { const int kp = j * 64 + crow(r, hi); if (kp >= qpos) p0[r] = -1e30f; if (kp + 32 >= qpos) p1[r] = -1e30f; } }
                f32x16 s0, s1;
#pragma unroll
                for (int r = 0; r < 16; ++r) { p0[r] = __builtin_amdgcn_exp2f(fminf(p0[r], 100.f)); p1[r] = __builtin_amdgcn_exp2f(fminf(p1[r], 100.f));
                    s0[r] = __builtin_amdgcn_rcpf(1.f + p0[r]); s1[r] = __builtin_amdgcn_rcpf(1.f + p1[r]); }
                float run = carry, bs[8];
#pragma unroll
                for (int i = 7; i >= 0; --i) { const f32x16& S = (i >= 4) ? s1 : s0; const int rb = 4 * (i & 3);
                    const float gs = (S[rb] * S[rb + 1]) * (S[rb + 2] * S[rb + 3]);
                    auto rr = __builtin_amdgcn_permlane32_swap(__float_as_uint(gs), __float_as_uint(gs), false, false);
                    const float glo = __uint_as_float(rr[0]), ghi = __uint_as_float(rr[1]);
                    const float exH = run; run *= ghi; const float exL = run; run *= glo;
                    bs[i] = hi ? exH : exL; }
                carry = run;
#pragma unroll
                for (int i = 0; i < 8; ++i) { f32x16& S = (i >= 4) ? s1 : s0; f32x16& Z = (i >= 4) ? p1 : p0; const int rb = 4 * (i & 3);
                    const float i3 = bs[i] * S[rb + 3], i2 = i3 * S[rb + 2], i1 = i2 * S[rb + 1], i0 = i1 * S[rb];
                    Z[rb + 3] *= i3; Z[rb + 2] *= i2; Z[rb + 1] *= i1; Z[rb] *= i0; }
            }
            PK4(p0, 0, pa0); PK4(p0, 8, pa1); PK4(p1, 0, pa2); PK4(p1, 8, pa3);
            pv_d0(o, vb, pa0, pa1, pa2, pa3);
        }
      }
    }
    if (wact && var < 1) {
        bf16_t* MIX = (bf16_t*)(p.ws + (var == 0 ? WS_MIX : WS_ACT));
        const size_t rbase = SAMPLE ? (size_t)(MP + b * TS) : (size_t)(b * SEQ + qb * 256 + wid * 32);
        constexpr int NIT = SAMPLE ? 4 : 8; const int er = lane >> 4, ec = (lane & 15) * 8;
        float rli[16];
        if (MODE == 0) { if (hi == 0) wsc[32 + r32] = l_reg; asm volatile("s_waitcnt lgkmcnt(0)" ::: "memory");
#pragma unroll
            for (int r = 0; r < 16; ++r) rli[r] = __builtin_amdgcn_rcpf(wsc[32 + crow(r, hi)]); }
#pragma unroll
        for (int r = 0; r < 16; ++r) { const int orow = crow(r, hi);
            if (!SAMPLE || orow < TS) {
#pragma unroll
                for (int d0 = 0; d0 < 4; ++d0) { float ov = o[d0][r]; if (MODE == 0) ov *= rli[r];
                    const unsigned pk = cvtpk(ov, 0.f); *(bf16_t*)(Qs + orow * 256 + (d0 * 32 + r32) * 2) = (bf16_t)(pk & 0xffffu); } } }
        asm volatile("s_waitcnt lgkmcnt(0)" ::: "memory");
        bf16x8 gt[NIT];
#pragma unroll
        for (int it = 0; it < NIT; ++it) gt[it] = __builtin_nontemporal_load((const bf16x8*)(P1q + 24 * HB + (rbase + it * 4 + er) * 128 + ec));
#pragma unroll
        for (int it = 0; it < NIT; ++it) { const int row = it * 4 + er; const bf16x8 mx = *(const bf16x8*)(Qs + row * 256 + ec * 2); f32x8 y;
#pragma unroll
            for (int i = 0; i < 8; ++i) y[i] = bf2f(mx[i]) * silu_fast(bf2f(gt[it][i]));
            *(bf16x8*)(MIX + (rbase + row) * DM + MODE * 1024 + h * HD + ec) = tobf8(y); }
    }
    __syncthreads();
#undef LOADT
#undef WRITET
}

__device__ __forceinline__ void attn_phase(const Params& p, char* lds) {
    const int G = gridDim.x;
    if ((blockIdx.x >> 3) & 1) {
        for (int u = blockIdx.x; u < 256; u += G) { attn_unit<0, true>(p, lds, u >> 3, u & 7, 0); attn_unit<1, true>(p, lds, u >> 3, u & 7, 0); }
        for (int u = blockIdx.x; u < 256; u += G) { const int bh = u & 31, i = u >> 5; attn_unit<0, false>(p, lds, bh >> 3, bh & 7, i); attn_unit<1, false>(p, lds, bh >> 3, bh & 7, 7 - i); }
    } else {
        for (int u = blockIdx.x; u < 256; u += G) { const int bh = u & 31, i = u >> 5; attn_unit<0, false>(p, lds, bh >> 3, bh & 7, i); attn_unit<1, false>(p, lds, bh >> 3, bh & 7, 7 - i); }
        for (int u = blockIdx.x; u < 256; u += G) { attn_unit<0, true>(p, lds, u >> 3, u & 7, 0); attn_unit<1, true>(p, lds, u >> 3, u & 7, 0); }
    }
}

__device__ __forceinline__ void spatial_phase(const Params& p, char* lds) {
    const int tid = threadIdx.x, wid = __builtin_amdgcn_readfirstlane(tid >> 6), lane = tid & 63, r32 = lane & 31, hi = lane >> 5;
    const bf16_t* UVZ = (const bf16_t*)(p.ws + WS_UVZ); bf16_t* ACT = (bf16_t*)(p.ws + WS_ACT);
    const float* st = (const float*)(p.ws + WS_STAT);
    const int sr = tid >> 4, sc = (tid & 15) * 8; const int tb = wid & 3, ch = wid >> 2;
    char* stg = lds + 65536 + wid * 8192;
    const int er = lane >> 4, ec = (lane & 15) * 8;
    const int t = 32 * tb + r32;
    bf16x8 raw[8]; float mu_[4], rs_[4]; bf16x8 pa[2][4]; int g_loaded = -1;
    float bsp_[16];
#define SP_DECODE(u_, samp_, g_, cidx_, rbase_, nrows_) const bool samp_ = (u_) >= 1024; const int g_ = (u_) & 15, cidx_ = samp_ ? (((u_) - 1024) >> 4) : ((u_) >> 4); \
        const size_t rbase_ = samp_ ? (size_t)(MP + cidx_ * TS) : (size_t)cidx_ * CCH; const int nrows_ = samp_ ? TS : CCH;
#define SP_PREFETCH(u_) do { SP_DECODE(u_, samp_, g_, cidx_, rbase_, nrows_) (void)cidx_;                                                              \
        _Pragma("unroll") for (int q = 0; q < 4; ++q) _Pragma("unroll") for (int hf = 0; hf < 2; ++hf) { const int s = (q >> 1) * 64 + sr + 32 * hf; raw[q * 2 + hf] = bf16x8{};   \
            if (s < nrows_) raw[q * 2 + hf] = __builtin_nontemporal_load((const bf16x8*)(UVZ + (size_t)MT * CW + ((size_t)g_ * MT + rbase_ + s) * 256 + (q & 1) * 128 + sc)); }                          \
        _Pragma("unroll") for (int k4 = 0; k4 < 4; ++k4) { const int s = (k4 >> 1) * 64 + sr + 32 * (k4 & 1); mu_[k4] = 0.f; rs_[k4] = 0.f;             \
            if (s < nrows_) { const size_t row = rbase_ + s; const float mu = st[ST_VSUM + row] * (1.f / CW); const float var = fmaxf(st[ST_VSQ + row] * (1.f / CW) - mu * mu, 0.f); mu_[k4] = mu; rs_[k4] = rsqrtf(var + LN_EPS); } } } while (0)
    int u = blockIdx.x;
    if (u < 1536) SP_PREFETCH(u);
    for (; u < 1536; u += gridDim.x) {
        SP_DECODE(u, samp, g, cidx, rbase, nrows)
        const bool act = samp ? (tb == 0) : true; const int nit = samp ? 4 : 8;
        if (g != g_loaded) { g_loaded = g;
#pragma unroll
            for (int st_ = 0; st_ < 2; ++st_)
#pragma unroll
                for (int ks = 0; ks < 4; ++ks) { const int s0 = 64 * st_ + 16 * ks + 8 * hi; const float* wp = p.w_sp + ((size_t)g * CCH + t) * CCH + s0;
                    const f32x4 a = *(const f32x4*)wp, c = *(const f32x4*)(wp + 4); f32x8 y;
#pragma unroll
                    for (int i = 0; i < 4; ++i) { y[i] = (s0 + i <= t) ? a[i] : 0.f; y[4 + i] = (s0 + 4 + i <= t) ? c[i] : 0.f; }
                    pa[st_][ks] = tobf8(y); }
#pragma unroll
            for (int r = 0; r < 16; ++r) bsp_[r] = p.b_sp[g * CCH + 32 * tb + crow(r, hi)]; }
        bf16x8 uu[8];
        if (act) {
#pragma unroll
            for (int it = 0; it < 8; ++it) if (it < nit) { const size_t row = rbase + 32 * tb + it * 4 + er; uu[it] = __builtin_nontemporal_load((const bf16x8*)(UVZ + ((size_t)g * MT + row) * 256 + ch * 128 + ec)); } }
#pragma unroll
        for (int q = 0; q < 4; ++q) { const int st_ = q >> 1, ch_ = q & 1; if (samp && st_ == 1) continue;
#pragma unroll
            for (int hf = 0; hf < 2; ++hf) { const int k = sr + 32 * hf, s = st_ * 64 + k; const int cc = ch_ * 128 + sc;
                bf16x8 w = {};
                if (s < nrows) { const float mu = mu_[st_ * 2 + hf], rs = rs_[st_ * 2 + hf];
                    const bf16x8 rw = raw[q * 2 + hf];
                    const f32x4 g0 = *(const f32x4*)(p.ln_g + g * GD + cc), g1 = *(const f32x4*)(p.ln_g + g * GD + cc + 4), b0 = *(const f32x4*)(p.ln_b + g * GD + cc), b1 = *(const f32x4*)(p.ln_b + g * GD + cc + 4);
                    f32x8 y;
#pragma unroll
                    for (int i = 0; i < 4; ++i) { y[i] = (bf2f(rw[i]) - mu) * rs * g0[i] + b0[i]; y[4 + i] = (bf2f(rw[4 + i]) - mu) * rs * g1[i] + b1[i]; }
                    if (samp) { float* d = p.out + O_SGV + (size_t)(cidx * TS + s) * CW + g * GD + cc; __builtin_nontemporal_store((f32x4){y[0], y[1], y[2], y[3]}, (f32x4*)d); __builtin_nontemporal_store((f32x4){y[4], y[5], y[6], y[7]}, (f32x4*)(d + 4)); }
                    w = tobf8(y); }
                *(bf16x8*)(lds + q * 16384 + v_st(k, sc)) = w; } }
        __syncthreads();
        if (u + (int)gridDim.x < 1536) SP_PREFETCH(u + (int)gridDim.x);
        if (act) {
            f32x16 o[4] = {};
            const int nst = (!samp && tb >= 2) ? 2 : 1;
            { const int vb = (int)(uintptr_t)(lds + ch * 16384) + v_rd_base(lane); pv_d0(o, vb, pa[0][0], pa[0][1], pa[0][2], pa[0][3]); }
            if (nst == 2) { const int vb = (int)(uintptr_t)(lds + (2 + ch) * 16384) + v_rd_base(lane); pv_d0(o, vb, pa[1][0], pa[1][1], pa[1][2], pa[1][3]); }
#pragma unroll
            for (int r = 0; r < 16; ++r) { const int tl = crow(r, hi); const float bsp = bsp_[r];
#pragma unroll
                for (int d0 = 0; d0 < 4; ++d0) { const unsigned pk = cvtpk(o[d0][r] + bsp, 0.f); *(bf16_t*)(stg + tl * 256 + (d0 * 32 + r32) * 2) = (bf16_t)(pk & 0xffffu); } }
            asm volatile("s_waitcnt lgkmcnt(0)" ::: "memory");
#pragma unroll
            for (int it = 0; it < 8; ++it) if (it < nit) { const int tl = it * 4 + er; const size_t row = rbase + 32 * tb + tl; const int col = g * GD + ch * 128 + ec;
                const bf16x8 mx = *(const bf16x8*)(stg + tl * 256 + ec * 2); f32x8 y;
#pragma unroll
                for (int i = 0; i < 8; ++i) y[i] = bf2f(uu[it][i]) * bf2f(mx[i]);
                *(bf16x8*)(ACT + row * CW + col) = tobf8(y); }
        }
        __syncthreads();
    }
#undef SP_DECODE
#undef SP_PREFETCH
}

__device__ __forceinline__ unsigned f2bf(float f) { unsigned u = __builtin_bit_cast(unsigned, f); return (u + 0x7fffu + ((u >> 16) & 1u)) >> 16; }
__device__ __forceinline__ unsigned pk2(float lo, float hi) { return f2bf(lo) | (f2bf(hi) << 16); }
constexpr int P0_I0 = (DM / 64) * (N1 / 32), P0_I1 = (DM / 64) * (DM / 32), P0_I2 = (DM / 64) * (N3 / 32), P0_I3 = (CW / 64) * (DM / 32), P0_NIT = P0_I0 + P0_I1 + P0_I2 + P0_I3;
__device__ __forceinline__ void p0_item_decode(const Params& p, int it, const float*& W, int& ld, int& nblk, int& K, bf16_t*& WT, bool& uzmap, int& r) {
    r = it; uzmap = false;
    if (r < P0_I0) { W = p.w_in0; ld = LDW0; nblk = N1 / 32; K = DM; WT = (bf16_t*)(p.ws + WS_W0T); return; } r -= P0_I0;
    if (r < P0_I1) { W = p.w_out0; ld = DM; nblk = DM / 32; K = DM; WT = (bf16_t*)(p.ws + WS_WO0T); return; } r -= P0_I1;
    if (r < P0_I2) { W = p.w_in1; ld = N3; nblk = N3 / 32; K = DM; WT = (bf16_t*)(p.ws + WS_W1T); uzmap = true; return; } r -= P0_I2;
    W = p.w_out1; ld = DM; nblk = DM / 32; K = CW; WT = (bf16_t*)(p.ws + WS_WO1T);
}
__device__ __forceinline__ void p0_item_load(const Params& p, int it, float (&t)[32], int lane) {
    const float* W; int ld, nblk, K, r; bf16_t* WT; bool uz; p0_item_decode(p, it, W, ld, nblk, K, WT, uz, r);
    const int kb = r / nblk, nb = r % nblk, k0 = 64 * kb, n0 = 32 * nb;
    const float* src = W + (size_t)(k0 + (lane >> 5)) * ld + n0 + (lane & 31);
#pragma unroll
    for (int i = 0; i < 32; ++i) t[i] = __builtin_nontemporal_load(src + (size_t)(2 * i) * ld);
}
__device__ __forceinline__ void p0_item_store(const Params& p, int it, const float (&t)[32], LAS float* scr, int lane) {
    const float* W; int ld, nblk, K, r; bf16_t* WT; bool uz; p0_item_decode(p, it, W, ld, nblk, K, WT, uz, r);
    const int kb = r / nblk, nb = r % nblk, k0 = 64 * kb, n0 = 32 * nb;
#pragma unroll
    for (int i = 0; i < 32; ++i) { const int kk = 2 * i + (lane >> 5); scr[kk * 33 + (lane & 31)] = t[i]; }
    asm volatile("s_waitcnt lgkmcnt(0)" ::: "memory");
    const int c = lane & 7;
#pragma unroll
    for (int j = 0; j < 4; ++j) { const int n = (lane >> 3) + 8 * j; const LAS float* s = scr + (8 * c) * 33 + n;
        u32x4 o; o.x = pk2(s[0 * 33], s[1 * 33]); o.y = pk2(s[2 * 33], s[3 * 33]); o.z = pk2(s[4 * 33], s[5 * 33]); o.w = pk2(s[6 * 33], s[7 * 33]);
        int nd = n0 + n;
        if (uz) { const int cc = nd & (CW - 1); nd = nd < CW ? 8 * (cc >> 2) + (cc & 3) : (nd < 2 * CW ? 2 * CW + cc : 8 * (cc >> 2) + 4 + (cc & 3)); }
        u32x4* dp = (u32x4*)(WT + (size_t)nd * K + k0 + 8 * c);
        if (it < P0_I0) *dp = o; else __builtin_nontemporal_store(o, dp); }
    asm volatile("s_waitcnt lgkmcnt(0)" ::: "memory");
}
__device__ __forceinline__ float log_sigmoid_f(float x) { return fminf(x, 0.f) - log1pf(expf(-fabsf(x))); }

__device__ __forceinline__ void p0_convert_items(const Params& p, LAS unsigned char* lds, int it_lo, int it_hi) {
    const int tid = threadIdx.x, wid = __builtin_amdgcn_readfirstlane(tid >> 6), lane = tid & 63;
    const int gw = blockIdx.x * 8 + wid, NGW = gridDim.x * 8;
    LAS float* scr = (LAS float*)(lds + wid * 8448);
    float ta[32], tb[32]; int it = it_lo + gw;
    if (it < it_hi) { p0_item_load(p, it, ta, lane);
        for (;;) { const int it2 = it + NGW; const bool h2 = it2 < it_hi; if (h2) p0_item_load(p, it2, tb, lane);
            p0_item_store(p, it, ta, scr, lane); if (!h2) break;
            const int it3 = it2 + NGW; const bool h3 = it3 < it_hi; if (h3) p0_item_load(p, it3, ta, lane);
            p0_item_store(p, it2, tb, scr, lane); if (!h3) break;
            it = it3; } }
    __syncthreads();
}
__device__ __forceinline__ void prologue_phase(const Params& p, unsigned char* ldsg) {
    const int tid = threadIdx.x, wid = __builtin_amdgcn_readfirstlane(tid >> 6), lane = tid & 63;
    const int gw = blockIdx.x * 8 + wid, NGW = gridDim.x * 8;
    LAS unsigned char* lds = (LAS unsigned char*)ldsg;
    { float* st = (float*)(p.ws + WS_STAT); for (int i = blockIdx.x * 512 + tid; i < 65536; i += gridDim.x * 512) st[i] = 0.f; }
    LAS float* wf = (LAS float*)(lds + 67584);
    float wv[32];
#pragma unroll
    for (int k = 0; k < 32; ++k) { const int i = tid + 512 * k; wv[k] = p.w_in0[(size_t)(i >> 3) * LDW0 + N1 + (i & 7)]; }
    p0_convert_items(p, lds, 0, P0_I0);
#pragma unroll
    for (int k = 0; k < 32; ++k) { const int i = tid + 512 * k; wf[(i >> 3) * 8 + ((i >> 5) << 2) + (i & 7)] = wv[k]; }
    __syncthreads();
    bf16_t* XN = (bf16_t*)(p.ws + WS_XN);
#define ROW_LOAD(m_, V_) do { const float* xr_ = (m_) < MP ? p.x_prompt + (size_t)(m_) * DM : p.x_sample + (size_t)((m_) - MP) * DM;                    \
        _Pragma("unroll") for (int j = 0; j < 8; ++j) V_[j] = __builtin_nontemporal_load((const f32x4*)(xr_ + 256 * j + 4 * lane)); } while (0)
#define ROW_PROC(m_, V_) do { float s = 0.f;                                                                                                            \
        _Pragma("unroll") for (int j = 0; j < 8; ++j) s += (V_[j][0] * V_[j][0] + V_[j][1] * V_[j][1]) + (V_[j][2] * V_[j][2] + V_[j][3] * V_[j][3]);      \
        const float rstd = rsqrtf(wave_sum(s) * (1.f / DM) + RMS_EPS);                                                                                  \
        float fa[8] = {0.f, 0.f, 0.f, 0.f, 0.f, 0.f, 0.f, 0.f};                                                                                          \
        _Pragma("unroll") for (int j = 0; j < 8; ++j) { const f32x4 gv = *(const f32x4*)(p.norm0_g + 256 * j + 4 * lane); const f32x4 hv = V_[j] * rstd * gv; \
            u32x2 w; w.x = cvtpk(hv[0], hv[1]); w.y = cvtpk(hv[2], hv[3]); *(u32x2*)(XN + (size_t)(m_) * DM + 256 * j + 4 * lane) = w;                    \
            _Pragma("unroll") for (int i = 0; i < 4; ++i) { const LAS f32x4* wp = (const LAS f32x4*)(wf + (256 * j + 4 * lane + i) * 8 + (64 * j + lane) * 4); const f32x4 w0 = wp[0], w1 = wp[1]; \
                fa[0] += hv[i] * w0[0]; fa[1] += hv[i] * w0[1]; fa[2] += hv[i] * w0[2]; fa[3] += hv[i] * w0[3];                                          \
                fa[4] += hv[i] * w1[0]; fa[5] += hv[i] * w1[1]; fa[6] += hv[i] * w1[2]; fa[7] += hv[i] * w1[3]; } }                                      \
        float mine = 0.f;                                                                                                                                \
        _Pragma("unroll") for (int c = 0; c < 8; ++c) { const float t = wave_sum(fa[c]); if (lane == c) mine = t; }                                      \
        if (lane < 8) { const float lf = log_sigmoid_f(mine + p.b_forget[lane]);                                                                         \
            if ((m_) < MP) p.out[O_FLP + (size_t)(m_) * 8 + lane] = lf; else p.out[O_FLS + (size_t)((m_) - MP) * 8 + lane] = lf; } } while (0)
    { f32x4 va[8], vb[8]; int m = gw;
        if (m < MT) { ROW_LOAD(m, va);
            for (;;) { const int m2 = m + NGW; const bool h2 = m2 < MT; if (h2) ROW_LOAD(m2, vb);
                ROW_PROC(m, va); if (!h2) break;
                const int m3 = m2 + NGW; const bool h3 = m3 < MT; if (h3) ROW_LOAD(m3, va);
                ROW_PROC(m2, vb); if (!h3) break;
                m = m3; } } }
#undef ROW_LOAD
#undef ROW_PROC
    __syncthreads();
}

__device__ __forceinline__ void final_phase(const Params& p) {
    const int tid = threadIdx.x, wid = tid >> 6, lane = tid & 63; const int gw = blockIdx.x * 8 + wid, NGW = gridDim.x * 8;
    const float* ssq2 = (const float*)(p.ws + WS_STAT) + ST_SSQ2;
    constexpr int RPW = 5;
    for (int m0 = gw; m0 < MT; m0 += RPW * NGW) {
        f32x4 v[RPW][8]; float rs[RPW];
#pragma unroll
        for (int k = 0; k < RPW; ++k) { const int m = m0 + k * NGW; rs[k] = 0.f;
            if (m < MT) { rs[k] = ssq2[m]; const float* yr = p.out + (size_t)m * DM;
#pragma unroll
                for (int j = 0; j < 8; ++j) v[k][j] = __builtin_nontemporal_load((const f32x4*)(yr + 256 * j + 4 * lane)); } }
        f32x4 gv[8];
#pragma unroll
        for (int j = 0; j < 8; ++j) gv[j] = *(const f32x4*)(p.final_g + 256 * j + 4 * lane);
#pragma unroll
        for (int k = 0; k < RPW; ++k) { const int m = m0 + k * NGW;
            if (m < MT) { const float r = rsqrtf(rs[k] * (1.f / DM) + RMS_EPS); float* yr = p.out + (size_t)m * DM;
#pragma unroll
                for (int j = 0; j < 8; ++j) __builtin_nontemporal_store(v[k][j] * r * gv[j], (f32x4*)(yr + 256 * j + 4 * lane)); } }
    }
}

#define RLX_AGENT __ATOMIC_RELAXED, __HIP_MEMORY_SCOPE_AGENT
#define LDS_WAIT() asm volatile("s_waitcnt lgkmcnt(0)" ::: "memory")
#define VM_WAIT() asm volatile("s_waitcnt vmcnt(0)" ::: "memory")
__device__ __forceinline__ unsigned long long rt() { return __builtin_amdgcn_s_memrealtime(); }
#define XB_TMO      128
#define XB_XCNT(j)  (256  + 64 * (j))
#define XB_XSUB(j)  (1280 + 64 * (j))
#define XB_XGEN(j)  (2304 + 64 * (j))
#define XB_TOP      3328
#define XB_TOPGEN   3392
#define XCD_BAR_WORDS 3456
#define XB_SPIN_CAP (1u << 18)

__device__ __forceinline__ unsigned xb_ld(unsigned* p)              { return __hip_atomic_load(p, __ATOMIC_RELAXED, __HIP_MEMORY_SCOPE_AGENT); }
__device__ __forceinline__ unsigned xb_add(unsigned* p, unsigned v) { return __hip_atomic_fetch_add(p, v, __ATOMIC_RELAXED, __HIP_MEMORY_SCOPE_AGENT); }
__device__ __forceinline__ unsigned xb_xcc_id() { return (unsigned)__builtin_amdgcn_s_getreg((3 << 11) | 20) & 0xFu; }
#define XB_SPIN(cond, bar) do { unsigned _sp = 0; while (cond) { __builtin_amdgcn_s_sleep(1); \
    if ((++_sp & 255u) == 0u) { if (xb_ld(&(bar)[XB_TMO])) break; if (_sp > XB_SPIN_CAP) { atomicAdd(&(bar)[XB_TMO], 1u); break; } } } } while (0)

struct XcdBarrier {
    unsigned* bar; unsigned x;
    volatile LAS unsigned* st;
};

__device__ __forceinline__ XcdBarrier xcd_barrier_post(unsigned* bar, volatile LAS unsigned* st) {
    XcdBarrier b; b.bar = bar; b.x = xb_xcc_id(); b.st = st;
    if (threadIdx.x == 0) (void)xb_add(&bar[XB_XCNT(b.x)], 1u);
    return b;
}
__device__ __forceinline__ void xcd_barrier_complete(unsigned* bar, unsigned x, unsigned& nloc, unsigned& nx) {
    const unsigned G = gridDim.x * gridDim.y * gridDim.z;
    unsigned sum, cnt, mine, sp = 0u;
    for (;;) {
        sum = 0u; cnt = 0u; mine = 0u;
#pragma unroll
        for (unsigned j = 0; j < 16; ++j) { const unsigned c = xb_ld(&bar[XB_XCNT(j)]); sum += c; cnt += (c > 0u) ? 1u : 0u; mine = (j == x) ? c : mine; }
        if (sum == G) break;
        __builtin_amdgcn_s_sleep(1);
        if ((++sp & 255u) == 0u) { if (xb_ld(&bar[XB_TMO])) break; if (sp > XB_SPIN_CAP) { atomicAdd(&bar[XB_TMO], 1u); break; } }
    }
    nloc = mine > 0u ? mine : 1u; nx = cnt > 0u ? cnt : 1u;
}

__device__ __forceinline__ void xcd_barrier(const XcdBarrier& b) {
    asm volatile("s_waitcnt vmcnt(0)" ::: "memory");
    __syncthreads();
    if (threadIdx.x == 0) {
        unsigned* bar = b.bar;
        __builtin_amdgcn_s_waitcnt(0);
        unsigned nloc = b.st[0], nx = b.st[1];
        if (nloc == 0u) { xcd_barrier_complete(bar, b.x, nloc, nx); b.st[0] = nloc; b.st[1] = nx; }
        const unsigned old = xb_add(&bar[XB_XSUB(b.x)], 1u);
        const unsigned gen = old / nloc;
        if (old + 1u == (gen + 1u) * nloc) {
            __builtin_amdgcn_fence(__ATOMIC_RELEASE, "agent");
            asm volatile("s_waitcnt vmcnt(0)" ::: "memory");
            const unsigned og = xb_add(&bar[XB_TOP], 1u);
            const unsigned tg = og / nx;
            if (og + 1u == (tg + 1u) * nx) xb_add(&bar[XB_TOPGEN], 1u);
            else XB_SPIN(xb_ld(&bar[XB_TOPGEN]) == tg, bar);
            __builtin_amdgcn_fence(__ATOMIC_ACQUIRE, "agent");
            xb_add(&bar[XB_XGEN(b.x)], 1u);
            asm volatile("s_waitcnt vmcnt(0)" ::: "memory");
        } else {
            XB_SPIN(xb_ld(&bar[XB_XGEN(b.x)]) == gen, bar);
            __builtin_amdgcn_fence(__ATOMIC_ACQUIRE, "agent");
            asm volatile("s_waitcnt vmcnt(0)" ::: "memory");
        }
    }
    __syncthreads();
}

constexpr int NPHASE = 8;
__global__ void __launch_bounds__(512, 2) mega_fwd(Params p) {
    extern __shared__ __attribute__((aligned(16))) unsigned char lds[];
    cg::grid_group grid = cg::this_grid();
    const int lo = p.ph_lo, hi = p.ph_hi;
#define IN(k) (lo <= (k) && (k) < hi)
    volatile LAS unsigned* MISC = (volatile LAS unsigned*)((LAS unsigned char*)lds + LDS_BYTES - 64);
    if (threadIdx.x < 2) MISC[threadIdx.x] = 0u;
    __syncthreads();
    const XcdBarrier bar = xcd_barrier_post((unsigned*)(p.ws + WS_BAR), MISC);
    if (hi > NPHASE) grid.sync();
#ifndef SEAM0_CG
#define SEAM0_CG 0
#endif
#define SEAM(k) do { if (IN(k) && IN((k) + 1)) { if (SEAM0_CG && (k) == 0) grid.sync(); else xcd_barrier(bar); } } while (0)
    float* stat = (float*)(p.ws + WS_STAT);
    if (IN(0)) prologue_phase(p, lds);
#if REP_PHASE == 0
    grid.sync(); prologue_phase(p, lds);
#endif
    SEAM(0);
    if (IN(1)) { pg8::Gemm g{(const bf16_t*)(p.ws + WS_XN), (const bf16_t*)(p.ws + WS_W0T), MP, N1, DM}; pg8::StaticOrder S; S.init(MP, N1, gridDim.x, blockIdx.x);
        Epi1 E{(bf16_t*)(p.ws + WS_P1), p.out};
        const bool conv_first = ((blockIdx.x >> 3) & 1) != 0;
        if (conv_first) p0_convert_items(p, (LAS unsigned char*)lds, P0_I0, P0_NIT);
        pg8::gemm_phase<Epi1, pg8::StaticOrder, true, true>((PG8_LAS unsigned char*)lds, g, S, E);
        gemm_small_phase<Epi1>((PG8_LAS unsigned char*)lds, g.A, g.Bt, MP, MS, N1, DM, E);
        if (!conv_first) p0_convert_items(p, (LAS unsigned char*)lds, P0_I0, P0_NIT);
#if REP_PHASE == 1
        grid.sync(); pg8::gemm_phase<Epi1, pg8::StaticOrder, true, true>((PG8_LAS unsigned char*)lds, g, S, E);
#endif
#if REP_PHASE == 11
        grid.sync(); gemm_small_phase<Epi1>((PG8_LAS unsigned char*)lds, g.A, g.Bt, MP, MS, N1, DM, E);
#endif
    }
    SEAM(1);
    if (IN(2)) attn_phase(p, (char*)lds);
#if REP_PHASE == 2
    grid.sync(); attn_phase(p, (char*)lds);
#endif
    SEAM(2);
    if (IN(3)) { pg8::Gemm g{(const bf16_t*)(p.ws + WS_MIX), (const bf16_t*)(p.ws + WS_WO0T), MP, DM, DM}; pg8::StaticOrder S; S.init(MP, DM, gridDim.x, blockIdx.x);
        Epi2 E{p.x_prompt, p.x_sample, p.norm1_g, (float*)(p.ws + WS_H1), (bf16_t*)(p.ws + WS_A1), stat + ST_SSQ1, true}; Epi2 Es = E; Es.pre = false;
        pg8::gemm_phase<Epi2, pg8::StaticOrder, true, true>((PG8_LAS unsigned char*)lds, g, S, E);
        gemm_small_phase<Epi2, 1  >((PG8_LAS unsigned char*)lds, g.A, g.Bt, MP, MS, DM, DM, Es, (float*)(p.ws + WS_SCR), (unsigned*)stat + ST_CNT2); }
    SEAM(3);
    if (IN(4)) { pg8::Gemm g{(const bf16_t*)(p.ws + WS_A1), (const bf16_t*)(p.ws + WS_W1T), MP, N3, DM}; pg8::StaticOrder S; S.init(MP, N3, gridDim.x, blockIdx.x);
        Epi3 E{stat + ST_SSQ1, (bf16_t*)(p.ws + WS_UVZ), stat + ST_VSUM, stat + ST_VSQ};
        pg8::gemm_phase<Epi3, pg8::StaticOrder, true, true>((PG8_LAS unsigned char*)lds, g, S, E);
        gemm_small_phase<Epi3>((PG8_LAS unsigned char*)lds, g.A, g.Bt, MP, MS, N3, DM, E); }
    SEAM(4);
    if (IN(5)) spatial_phase(p, (char*)lds);
#if REP_PHASE == 5
    grid.sync(); spatial_phase(p, (char*)lds);
#endif
    SEAM(5);
    if (IN(6)) { pg8::Gemm g{(const bf16_t*)(p.ws + WS_ACT), (const bf16_t*)(p.ws + WS_WO1T), MP, DM, CW}; pg8::StaticOrder S; S.init(MP, DM, gridDim.x, blockIdx.x);
        Epi4 E{(const float*)(p.ws + WS_H1), p.out, stat + ST_SSQ2, true}; Epi4 Es = E; Es.pre = false;
        pg8::gemm_phase<Epi4, pg8::StaticOrder, true, true>((PG8_LAS unsigned char*)lds, g, S, E);
        gemm_small_phase<Epi4, 4>((PG8_LAS unsigned char*)lds, g.A, g.Bt, MP, MS, DM, CW, Es, (float*)(p.ws + WS_SCR), (unsigned*)stat + ST_CNT4);
#if REP_PHASE == 64
        { xcd_barrier(bar); Epi4 Ed{(const float*)(p.ws + WS_H1), (float*)(p.ws + WS_UVZ), stat + ST_VSUM, false}; gemm_small_phase<Epi4, 4>((PG8_LAS unsigned char*)lds, g.A, g.Bt, MP, MS, DM, CW, Ed, (float*)(p.ws + WS_SCR), (unsigned*)stat + ST_CNT4 + 200); }
#endif
#if REP_PHASE == 65
        { xcd_barrier(bar); Epi4 Ed{(const float*)(p.ws + WS_H1), (float*)(p.ws + WS_UVZ), stat + ST_VSUM, false}; gemm_small_phase<Epi4, 1>((PG8_LAS unsigned char*)lds, g.A, g.Bt, MP, MS, DM, CW, Ed); }
#endif
    }
    SEAM(6);
#if REP_PHASE == 90
    xcd_barrier(bar); xcd_barrier(bar); xcd_barrier(bar); xcd_barrier(bar); xcd_barrier(bar); xcd_barrier(bar); xcd_barrier(bar); xcd_barrier(bar);
#endif
    if (IN(7)) final_phase(p);
#undef IN
#undef SEAM
}

extern "C" void kernel_launch(void* const* d_in, const int* in_sizes, int n_in, void* d_out, int out_size, void* d_ws, size_t ws_size, hipStream_t stream) {
    static int grid = 0;
    if (grid == 0) {
        if (n_in != 19 || out_size != (int)O_END || ws_size < WS_END) { fprintf(stderr, "kernel_launch: unexpected shapes: n_in %d out %d (want %zu) ws %zu (want %zu)\n", n_in, out_size, (size_t)O_END, ws_size, (size_t)WS_END); grid = -1; return; }
        int dev = 0, cus = 0, per_cu = 0;
        hipGetDevice(&dev); hipDeviceGetAttribute(&cus, hipDeviceAttributeMultiprocessorCount, dev);
        if (hipFuncSetAttribute((const void*)mega_fwd, hipFuncAttributeMaxDynamicSharedMemorySize, LDS_BYTES) != hipSuccess) { fprintf(stderr, "kernel_launch: hipFuncSetAttribute failed\n"); grid = -1; return; }
        if (hipOccupancyMaxActiveBlocksPerMultiprocessor(&per_cu, (const void*)mega_fwd, 512, LDS_BYTES) != hipSuccess || per_cu < 1) { fprintf(stderr, "kernel_launch: occupancy query failed (%d)\n", per_cu); per_cu = 1; }
        (void)hipGetLastError();
        grid = cus * per_cu;
        fprintf(stderr, "kernel_launch: grid %d (%d CUs x %d)\n", grid, cus, per_cu);
    }
    if (grid < 0) return;
    Params p{};
    p.x_prompt = (const float*)d_in[0]; p.x_sample = (const float*)d_in[1]; p.cfk = (const float*)d_in[2]; p.cfv = (const float*)d_in[3]; p.cflogf = (const float*)d_in[4];
    p.csk = (const float*)d_in[5]; p.csv = (const float*)d_in[6]; p.norm0_g = (const float*)d_in[7]; p.w_in0 = (const float*)d_in[8]; p.b_forget = (const float*)d_in[9];
    p.w_out0 = (const float*)d_in[10]; p.norm1_g = (const float*)d_in[11]; p.w_in1 = (const float*)d_in[12]; p.ln_g = (const float*)d_in[13]; p.ln_b = (const float*)d_in[14];
    p.w_sp = (const float*)d_in[15]; p.b_sp = (const float*)d_in[16]; p.w_out1 = (const float*)d_in[17]; p.final_g = (const float*)d_in[18];
    p.out = (float*)d_out; p.ws = (unsigned char*)d_ws;
#if MK_N_LAUNCHES == 1
    p.ph_lo = 0; p.ph_hi = NPHASE;
    if (hipMemsetAsync((char*)d_ws + WS_BAR, 0, XCD_BAR_WORDS * 4, stream) != hipSuccess) { fprintf(stderr, "kernel_launch: hipMemsetAsync of the barrier words failed\n"); return; }
    void* args[] = {&p};
    hipError_t e = hipLaunchCooperativeKernel((const void*)mega_fwd, dim3(grid), dim3(512), args, LDS_BYTES, stream);
    if (e != hipSuccess) fprintf(stderr, "kernel_launch: cooperative launch failed: %s (grid %d)\n", hipGetErrorString(e), grid);
#else
    for (int k = 0; k < NPHASE; ++k) { p.ph_lo = k; p.ph_hi = k + 1; hipLaunchKernelGGL(mega_fwd, dim3(grid), dim3(512), LDS_BYTES, stream, p); }
    hipError_t e = hipPeekAtLastError();
    if (e != hipSuccess) fprintf(stderr, "kernel_launch: launch failed: %s\n", hipGetErrorString(e));
#endif
}
```

```cpp
#include <hip/hip_runtime.h>
#include <hip/hip_cooperative_groups.h>
#include <cstdio>
#include <cstdint>
namespace cg = cooperative_groups;

#ifndef MK_N_LAUNCHES
#define MK_N_LAUNCHES 1
#endif
#ifndef REP_PHASE
#define REP_PHASE -1
#endif
namespace pg8 {
#define PG8_LAS __attribute__((address_space(3)))
typedef unsigned short bf16_t;
typedef short bf16x8 __attribute__((ext_vector_type(8)));
typedef float f32x4 __attribute__((ext_vector_type(4)));
typedef unsigned u32x4 __attribute__((ext_vector_type(4)));
constexpr int BM = 256, BK = 64, HALF = 128, HTB = HALF * BK * 2  , STAGE_BYTES = 8 * HTB, NXCD = 8, WGM = 4;

__host__ __device__ __forceinline__ int lds_byte(int r, int c) { const int st = (r >> 4) * 2 + (c >> 5), rr = r & 15, cc = c & 31, ob = rr * 64 + cc * 2; return st * 1024 + (ob ^ (((ob >> 9) & 1) << 5)); }
__host__ __device__ __forceinline__ void stage_rc(int b, int& R, int& C) { const int st = b / 1024, sb = b % 1024, swz = sb ^ (((sb >> 9) & 1) << 5); R = (st >> 1) * 16 + swz / 64; C = (st & 1) * 32 + (swz % 64) / 2; }
__host__ __device__ __forceinline__ int perm32(int rho) { const int n = rho >> 4, i = rho & 15; return 8 * (i >> 2) + 4 * n + (i & 3); }

struct Unit { int pm, pn; };
struct Gemm { const bf16_t* A; const bf16_t* Bt; int M, N, K; };

struct StaticOrder {
    int nM, nN, nwg, G, c;
    __host__ __device__ void init(int M, int N, int G_, int c_) { nM = M / BM; nN = N / BM; nwg = nM * nN; G = G_; c = c_; }
    __host__ __device__ bool next(int i, Unit& u) const {
        const long L = (long)i * G + c; if (L >= nwg) return false;
        int wgid = (int)L; { const int q = nwg / NXCD, r = nwg % NXCD, xcd = wgid % NXCD, off = wgid / NXCD; wgid = (xcd < r ? xcd * (q + 1) : r * (q + 1) + (xcd - r) * q) + off; }
        const int nig = WGM * nN, gid = wgid / nig, fm = gid * WGM, gsz = (nM - fm) < WGM ? (nM - fm) : WGM;
        u.pm = fm + ((wgid % nig) % gsz); u.pn = (wgid % nig) / gsz; return true;
    }
    __device__ __forceinline__ void a_ready(const Unit&) const {}
    __device__ __forceinline__ void done(const Unit&) const {}
};

__device__ __forceinline__ unsigned cvt_pk_bf16(float lo, float hi) { unsigned r; asm volatile("v_cvt_pk_bf16_f32 %0, %1, %2" : "=v"(r) : "v"(lo), "v"(hi)); return r; }
typedef float f32x2 __attribute__((ext_vector_type(2)));
template <class Epi, class Sched, bool ALIGN_EPI = false, bool SP2 = false>
__device__ __forceinline__ void gemm_phase(PG8_LAS unsigned char* lds, const Gemm g, const Sched& S, const Epi& E) {
    const int tid = threadIdx.x, wid = __builtin_amdgcn_readfirstlane(tid >> 6), lane = tid & 63, wr = wid >> 2, wc = wid & 3, fr = lane & 15, fq = lane >> 4;
    const int K = g.K, nt = K / BK;
    unsigned voffA[2], voffB[2];
#pragma unroll
    for (int i = 0; i < 2; ++i) { int R, C; stage_rc(tid * 16 + i * 8192, R, C); const int Rb = Epi::PERM ? ((R & ~31) + perm32(R & 31)) : R;
        voffA[i] = (unsigned)(R * K + C) * 2u; voffB[i] = (unsigned)(Rb * K + C) * 2u; }
    const size_t kstep = (size_t)(BK * 2);
    const size_t hstep = (size_t)HALF * K * 2;
    const size_t tstep = 2 * hstep;
    const unsigned ldsw = (unsigned)wid * 1024u;
    const int aoff = lds_byte(wr * 64 + fr, fq * 8), boff = lds_byte(wc * 32 + fr, fq * 8);
#define PG8_SA(b, h) (((b) * 2 + (h)) * HTB)
#define PG8_SB(b, h) ((4 + (b) * 2 + (h)) * HTB)
#define PG8_STAGE(bufoff, gbase, voff) do { _Pragma("unroll") for (int _i = 0; _i < 2; ++_i) \
        __builtin_amdgcn_global_load_lds((const unsigned*)((const char*)(gbase) + (voff)[_i]), (PG8_LAS unsigned*)(lds + (bufoff) + ldsw + _i * 8192), 16, 0, 0); } while (0)
#define PG8_LDA(dst, b, h) do { _Pragma("unroll") for (int m = 0; m < 4; ++m) _Pragma("unroll") for (int k = 0; k < 2; ++k) dst[m][k] = *(const PG8_LAS bf16x8*)(lds + PG8_SA(b, h) + aoff + m * 2048 + k * 1024); } while (0)
#define PG8_LDB(dst, b, h) do { _Pragma("unroll") for (int n = 0; n < 2; ++n) _Pragma("unroll") for (int k = 0; k < 2; ++k) dst[n][k] = *(const PG8_LAS bf16x8*)(lds + PG8_SB(b, h) + boff + n * 2048 + k * 1024); } while (0)
#define PG8_MMA(ai, bj, At, Bt) do { __builtin_amdgcn_s_setprio(1); _Pragma("unroll") for (int m = 0; m < 4; ++m) _Pragma("unroll") for (int n = 0; n < 2; ++n) _Pragma("unroll") for (int k = 0; k < 2; ++k) \
        acc[ai][bj][m][n] = __builtin_amdgcn_mfma_f32_16x16x32_bf16(Bt[n][k], At[m][k], acc[ai][bj][m][n], 0, 0, 0); __builtin_amdgcn_s_setprio(0); } while (0)
#define PG8_WAIT_V(n) asm volatile("s_waitcnt vmcnt(" #n ")" ::: "memory")
#define PG8_WAIT_L(n) asm volatile("s_waitcnt lgkmcnt(" #n ")" ::: "memory")
#define PG8_BAR __builtin_amdgcn_s_barrier()
#define PG8_SCHED __builtin_amdgcn_sched_barrier(0)
    Unit cur, nxt; int ui = 0;
    if (!S.next(0, cur)) return;
    f32x4 acc[2][2][4][2];
#pragma unroll
    for (int a = 0; a < 2; ++a)
#pragma unroll
        for (int b = 0; b < 2; ++b)
#pragma unroll
            for (int m = 0; m < 4; ++m)
#pragma unroll
                for (int n = 0; n < 2; ++n) acc[a][b][m][n] = (f32x4){0.f, 0.f, 0.f, 0.f};
    if constexpr (Epi::ACC_INIT) E.init(acc, cur, wr, wc, fr, fq);
    bf16x8 At[4][2], B0[2][2], B1[2][2];
    const char* cA = (const char*)g.A + (size_t)cur.pm * tstep; const char* cB = (const char*)g.Bt + (size_t)cur.pn * tstep;
    S.a_ready(cur);
    if constexpr (SP2) {
        PG8_STAGE(PG8_SB(0, 0), cB, voffB); PG8_STAGE(PG8_SB(0, 1), cB + hstep, voffB); PG8_STAGE(PG8_SA(0, 0), cA, voffA); PG8_STAGE(PG8_SA(0, 1), cA + hstep, voffA);
        if (wr == 1) PG8_BAR;
        PG8_WAIT_V(2); PG8_BAR;
        PG8_STAGE(PG8_SB(1, 0), cB + kstep, voffB); PG8_STAGE(PG8_SA(1, 0), cA + kstep, voffA); PG8_STAGE(PG8_SB(1, 1), cB + hstep + kstep, voffB);
        PG8_WAIT_V(6); PG8_BAR;
    } else {
        PG8_STAGE(PG8_SB(0, 0), cB, voffB); PG8_STAGE(PG8_SA(0, 0), cA, voffA); PG8_STAGE(PG8_SB(0, 1), cB + hstep, voffB); PG8_STAGE(PG8_SA(0, 1), cA + hstep, voffA);
        if (wr == 1) PG8_BAR;
        PG8_WAIT_V(4); PG8_BAR;
        PG8_STAGE(PG8_SB(1, 0), cB + kstep, voffB); PG8_STAGE(PG8_SA(1, 0), cA + kstep, voffA); PG8_STAGE(PG8_SB(1, 1), cB + hstep + kstep, voffB);
        PG8_WAIT_V(6); PG8_BAR;
    }
    for (;;) {
        const bool has_next = S.next(ui + 1, nxt);
        const char* nA = has_next ? (const char*)g.A + (size_t)nxt.pm * tstep : cA; const char* nB = has_next ? (const char*)g.Bt + (size_t)nxt.pn * tstep : cB;
        for (int t = 0; t < nt; t += 2) {
            const bool last = (t == nt - 2);
            const char* a1 = cA + (size_t)(t + 1) * kstep;
            const char* a2 = last ? nA : cA + (size_t)(t + 2) * kstep; const char* b2 = last ? nB : cB + (size_t)(t + 2) * kstep;
            const char* a3 = a2 + kstep; const char* b3 = b2 + kstep;
            if (last && has_next) S.a_ready(nxt);
            if constexpr (SP2) {
            PG8_LDB(B0, 0, 0); PG8_LDB(B1, 0, 1); PG8_SCHED; PG8_LDA(At, 0, 0); PG8_STAGE(PG8_SA(1, 1), a1 + hstep, voffA);
            PG8_WAIT_V(8); PG8_WAIT_L(0); PG8_BAR; PG8_MMA(0, 0, At, B0); PG8_MMA(0, 1, At, B1); PG8_BAR; PG8_SCHED;
            PG8_LDA(At, 0, 1); PG8_STAGE(PG8_SB(0, 0), b2, voffB); PG8_STAGE(PG8_SB(0, 1), b2 + hstep, voffB); PG8_STAGE(PG8_SA(0, 0), a2, voffA);
            PG8_WAIT_V(8); PG8_WAIT_L(0); PG8_BAR; PG8_MMA(1, 0, At, B0); PG8_MMA(1, 1, At, B1); PG8_BAR; PG8_SCHED;
            PG8_LDB(B0, 1, 0); PG8_LDB(B1, 1, 1); PG8_SCHED; PG8_LDA(At, 1, 0); PG8_STAGE(PG8_SA(0, 1), a2 + hstep, voffA);
            PG8_WAIT_V(8); PG8_WAIT_L(0); PG8_BAR; PG8_MMA(0, 0, At, B0); PG8_MMA(0, 1, At, B1); PG8_BAR; PG8_SCHED;
            PG8_LDA(At, 1, 1); PG8_STAGE(PG8_SB(1, 0), b3, voffB); PG8_STAGE(PG8_SB(1, 1), b3 + hstep, voffB); PG8_STAGE(PG8_SA(1, 0), a3, voffA);
            PG8_WAIT_V(8); PG8_WAIT_L(0); PG8_BAR; PG8_MMA(1, 0, At, B0); PG8_MMA(1, 1, At, B1); PG8_BAR; PG8_SCHED;
            } else {
            PG8_LDB(B0, 0, 0); PG8_SCHED; PG8_LDA(At, 0, 0); PG8_STAGE(PG8_SA(1, 1), a1 + hstep, voffA);
            PG8_WAIT_L(8); PG8_BAR; PG8_WAIT_L(0); PG8_MMA(0, 0, At, B0); PG8_BAR; PG8_SCHED;
            PG8_LDB(B1, 0, 1); PG8_STAGE(PG8_SB(0, 0), b2, voffB);
            PG8_BAR; PG8_WAIT_L(0); PG8_MMA(0, 1, At, B1); PG8_BAR;
            PG8_LDA(At, 0, 1); PG8_STAGE(PG8_SA(0, 0), a2, voffA);
            PG8_BAR; PG8_WAIT_L(0); PG8_MMA(1, 0, At, B0); PG8_BAR; PG8_SCHED;
            PG8_STAGE(PG8_SB(0, 1), b2 + hstep, voffB);
            PG8_WAIT_V(6); PG8_BAR; PG8_MMA(1, 1, At, B1); PG8_BAR;
            PG8_LDB(B0, 1, 0); PG8_SCHED; PG8_LDA(At, 1, 0); PG8_STAGE(PG8_SA(0, 1), a2 + hstep, voffA);
            PG8_WAIT_L(8); PG8_BAR; PG8_WAIT_L(0); PG8_MMA(0, 0, At, B0); PG8_BAR; PG8_SCHED;
            PG8_LDB(B1, 1, 1); PG8_STAGE(PG8_SB(1, 0), b3, voffB);
            PG8_BAR; PG8_WAIT_L(0); PG8_MMA(0, 1, At, B1); PG8_BAR;
            PG8_LDA(At, 1, 1); PG8_STAGE(PG8_SA(1, 0), a3, voffA);
            PG8_BAR; PG8_WAIT_L(0); PG8_MMA(1, 0, At, B0); PG8_BAR; PG8_SCHED;
            PG8_STAGE(PG8_SB(1, 1), b3 + hstep, voffB);
            PG8_WAIT_V(6); PG8_BAR; PG8_MMA(1, 1, At, B1); PG8_BAR;
            }
        }
        if constexpr (ALIGN_EPI) { if (wr == 0) PG8_BAR; }
        if constexpr (!Epi::AFTER_DRAIN) { E(acc, cur, wr, wc, fr, fq); S.done(cur); }
        if (!has_next) break;
#pragma unroll
        for (int a = 0; a < 2; ++a)
#pragma unroll
            for (int b = 0; b < 2; ++b)
#pragma unroll
                for (int m = 0; m < 4; ++m)
#pragma unroll
                    for (int n = 0; n < 2; ++n) acc[a][b][m][n] = (f32x4){0.f, 0.f, 0.f, 0.f};
        if constexpr (Epi::ACC_INIT) E.init(acc, nxt, wr, wc, fr, fq);
        cur = nxt; cA = nA; cB = nB; ++ui;
        if constexpr (ALIGN_EPI) { if (wr == 1) PG8_BAR; }
    }
    PG8_WAIT_V(0);
    if constexpr (!ALIGN_EPI) { if (wr == 0) PG8_BAR; }
    PG8_BAR;
    if constexpr (Epi::AFTER_DRAIN) { E.fused(acc, cur, wr, wc, fr, fq, lds, wid, lane); S.done(cur); }
#undef PG8_SA
#undef PG8_SB
#undef PG8_STAGE
#undef PG8_LDA
#undef PG8_LDB
#undef PG8_MMA
#undef PG8_WAIT_V
#undef PG8_WAIT_L
#undef PG8_BAR
#undef PG8_SCHED
}
}

constexpr int DM = 2048, MP = 8192, MS = 512, MT = MP + MS, SEQ = 2048, TS = 16, PAST = 1024, NH = 8, HD = 128;
constexpr int N1 = 8192, LDW0 = 8200, N3 = 12288, CW = 4096, NG = 16, GD = 256, CCH = 128;
constexpr float RMS_EPS = 1e-6f, LN_EPS = 1e-5f, LOG2E = 1.4426950408889634f;
constexpr float QSCALE = 0.08838834764831845f * 1.4426950408889634f;
constexpr size_t O_YP = 0, O_YS = O_YP + (size_t)MP * DM, O_FKP = O_YS + (size_t)MS * DM, O_FVP = O_FKP + (size_t)MP * 1024, O_FLP = O_FVP + (size_t)MP * 1024,
    O_FKS = O_FLP + (size_t)MP * 8, O_FVS = O_FKS + (size_t)MS * 1024, O_FLS = O_FVS + (size_t)MS * 1024, O_SKP = O_FLS + (size_t)MS * 8, O_SVP = O_SKP + (size_t)MP * 1024,
    O_SKS = O_SVP + (size_t)MP * 1024, O_SVS = O_SKS + (size_t)MS * 1024, O_SGV = O_SVS + (size_t)MS * 1024, O_END = O_SGV + (size_t)MS * CW;
constexpr size_t MiB = 1u << 20;
constexpr size_t WS_STAT = 0, WS_W0T = 1 * MiB, WS_WO0T = 33 * MiB, WS_W1T = 41 * MiB, WS_WO1T = 89 * MiB, WS_XN = 105 * MiB, WS_P1 = 139 * MiB, WS_MIX = 275 * MiB,
    WS_UVZ = 105 * MiB  , WS_H1 = 309 * MiB, WS_A1 = 377 * MiB, WS_ACT = 411 * MiB, WS_SCR = 479 * MiB  , WS_BAR = 495 * MiB  , WS_END = 496 * MiB;
constexpr int ST_SSQ1 = 0, ST_VSUM = 16384, ST_VSQ = 32768, ST_SSQ2 = 49152, ST_CNT2 = 60000, ST_CNT4 = 61000;
constexpr int LDS_BYTES = 131072 + 16384;

typedef unsigned short bf16_t;
typedef short bf16x8 __attribute__((ext_vector_type(8)));
typedef short s16x4 __attribute__((ext_vector_type(4)));
typedef float f32x4 __attribute__((ext_vector_type(4)));
typedef float f32x8 __attribute__((ext_vector_type(8)));
typedef float f32x16 __attribute__((ext_vector_type(16)));
typedef unsigned u32x4 __attribute__((ext_vector_type(4)));
typedef unsigned u32x2 __attribute__((ext_vector_type(2)));
#define LAS __attribute__((address_space(3)))
#define SBAR() __builtin_amdgcn_sched_barrier(0)

struct Params {
    const float *x_prompt, *x_sample, *cfk, *cfv, *cflogf, *csk, *csv, *norm0_g, *w_in0, *b_forget, *w_out0, *norm1_g, *w_in1, *ln_g, *ln_b, *w_sp, *b_sp, *w_out1, *final_g;
    float* out; unsigned char* ws; int ph_lo, ph_hi;
};

__device__ __forceinline__ unsigned cvtpk(float lo, float hi) { unsigned r; asm volatile("v_cvt_pk_bf16_f32 %0, %1, %2" : "=v"(r) : "v"(lo), "v"(hi)); return r; }
__device__ __forceinline__ float wave_sum(float v) {
#pragma unroll
    for (int o = 1; o < 64; o <<= 1) v += __shfl_xor(v, o);
    return v;
}
__device__ __forceinline__ float bf2f(short s) { return __uint_as_float(((unsigned)(unsigned short)s) << 16); }
__device__ __forceinline__ float silu_f(float g) { return g / (1.f + __expf(-g)); }

using pg8::Unit;
#define EPI_TILE_OP() __device__ __forceinline__ void operator()(const f32x4 (&acc)[2][2][4][2], const Unit& u, int wr, int wc, int fr, int fq) const { \
    _Pragma("unroll") for (int ai = 0; ai < 2; ++ai) _Pragma("unroll") for (int bj = 0; bj < 2; ++bj) quad(acc[ai][bj], u.pm * 256 + ai * 128, u.pn * 256 + bj * 128, wr, wc, fr, fq); }
__device__ __forceinline__ float silu_fast(float g) { return g * __builtin_amdgcn_rcpf(1.f + __builtin_amdgcn_exp2f(-g * LOG2E)); }
struct Epi1 {
    static constexpr bool PERM = true, AFTER_DRAIN = false, ACC_INIT = false;
    bf16_t* P1; float* out;
    __device__ __forceinline__ void quad(const f32x4 (&a)[4][2], int rowq, int colq, int wr, int wc, int fr, int fq) const {
        const int seg = colq >> 10; const bool samp = rowq >= MP;
        const float sc = (seg == 0 || seg == 4) ? QSCALE : 1.f;
        float* fdst = nullptr;
        if (seg == 1) fdst = out + (samp ? O_FKS : O_FKP); else if (seg == 2) fdst = out + (samp ? O_FVS : O_FVP);
        else if (seg == 5) fdst = out + (samp ? O_SKS : O_SKP); else if (seg == 6) fdst = out + (samp ? O_SVS : O_SVP);
        const int row0 = rowq + wr * 64 + fr, col0 = colq + wc * 32 + 8 * fq, lro = samp ? MP : 0;
#pragma unroll
        for (int m = 0; m < 4; ++m) { const int row = row0 + m * 16; const f32x4 v0 = a[m][0], v1 = a[m][1];
            u32x4 w; w.x = cvtpk(v0[0] * sc, v0[1] * sc); w.y = cvtpk(v0[2] * sc, v0[3] * sc); w.z = cvtpk(v1[0] * sc, v1[1] * sc); w.w = cvtpk(v1[2] * sc, v1[3] * sc);
            *(u32x4*)(P1 + ((size_t)(col0 >> 7) * MT + row) * 128 + (col0 & 127)) = w;
            if (fdst) { float* d = fdst + (size_t)(row - lro) * 1024 + (col0 & 1023); __builtin_nontemporal_store(v0, (f32x4*)d); __builtin_nontemporal_store(v1, (f32x4*)(d + 4)); } }
    }
    EPI_TILE_OP()
};
struct Epi2 {
    static constexpr bool PERM = false, AFTER_DRAIN = false, ACC_INIT = true;
    const float *xp, *xs, *g1; float* H1; bf16_t* A1; float* ssq; bool pre;
    __device__ __forceinline__ void init(f32x4 (&acc)[2][2][4][2], const Unit& u, int wr, int wc, int fr, int fq) const {
#pragma unroll
        for (int ai = 0; ai < 2; ++ai)
#pragma unroll
            for (int m = 0; m < 4; ++m) { const int row = u.pm * 256 + ai * 128 + wr * 64 + m * 16 + fr; const float* xr = row < MP ? xp + (size_t)row * DM : xs + (size_t)(row - MP) * DM;
#pragma unroll
                for (int bj = 0; bj < 2; ++bj)
#pragma unroll
                    for (int n = 0; n < 2; ++n) acc[ai][bj][m][n] = __builtin_nontemporal_load((const f32x4*)(xr + u.pn * 256 + bj * 128 + wc * 32 + 4 * fq + n * 16)); }
    }
    __device__ __forceinline__ void quad(const f32x4 (&a)[4][2], int rowq, int colq, int wr, int wc, int fr, int fq) const {
        const int col0 = colq + wc * 32 + 4 * fq;
#pragma unroll
        for (int m = 0; m < 4; ++m) { const int row = rowq + wr * 64 + m * 16 + fr;
            const float* xr = row < MP ? xp + (size_t)row * DM : xs + (size_t)(row - MP) * DM; float s = 0.f;
#pragma unroll
            for (int n = 0; n < 2; ++n) { const int c = col0 + n * 16; f32x4 hv = a[m][n]; if (!pre) hv += *(const f32x4*)(xr + c);
                __builtin_nontemporal_store(hv, (f32x4*)(H1 + (size_t)row * DM + c)); s += (hv[0] * hv[0] + hv[1] * hv[1]) + (hv[2] * hv[2] + hv[3] * hv[3]);
                const f32x4 gv = *(const f32x4*)(g1 + c); u32x2 w; w.x = cvtpk(hv[0] * gv[0], hv[1] * gv[1]); w.y = cvtpk(hv[2] * gv[2], hv[3] * gv[3]);
                *(u32x2*)(A1 + (size_t)row * DM + c) = w; }
            s += __shfl_xor(s, 16); s += __shfl_xor(s, 32);
            if (fq == 0) unsafeAtomicAdd(ssq + row, s); }
    }
    EPI_TILE_OP()
};
struct Epi3 {
    static constexpr bool PERM = true, AFTER_DRAIN = false, ACC_INIT = false;
    const float* ssq1; bf16_t* UZV; float *vsum, *vsq;
    __device__ __forceinline__ void quad(const f32x4 (&a)[4][2], int rowq, int colq, int wr, int wc, int fr, int fq) const {
        const int row0 = rowq + wr * 64 + fr, col0 = colq + wc * 32 + 8 * fq;
        if (colq < 2 * CW) {
#pragma unroll
            for (int m = 0; m < 4; ++m) { const int row = row0 + m * 16; const float rs = rsqrtf(ssq1[row] * (1.f / DM) + RMS_EPS);
                const f32x4 uu = a[m][0] * rs, zz = a[m][1] * rs; u32x2 w;
                w.x = cvtpk(uu[0] * silu_fast(zz[0]), uu[1] * silu_fast(zz[1])); w.y = cvtpk(uu[2] * silu_fast(zz[2]), uu[3] * silu_fast(zz[3]));
                const int cu = col0 >> 1; *(u32x2*)(UZV + ((size_t)(cu >> 8) * MT + row) * 256 + (cu & 255)) = w; }
        } else {
#pragma unroll
            for (int m = 0; m < 4; ++m) { const int row = row0 + m * 16; const float rs = rsqrtf(ssq1[row] * (1.f / DM) + RMS_EPS);
                const f32x4 v0 = a[m][0] * rs, v1 = a[m][1] * rs;
                u32x4 w; w.x = cvtpk(v0[0], v0[1]); w.y = cvtpk(v0[2], v0[3]); w.z = cvtpk(v1[0], v1[1]); w.w = cvtpk(v1[2], v1[3]);
                const int cv = col0 - 2 * CW; *(u32x4*)(UZV + (size_t)MT * CW + ((size_t)(cv >> 8) * MT + row) * 256 + (cv & 255)) = w;
                float s = ((v0[0] + v0[1]) + (v0[2] + v0[3])) + ((v1[0] + v1[1]) + (v1[2] + v1[3]));
                float q = ((v0[0] * v0[0] + v0[1] * v0[1]) + (v0[2] * v0[2] + v0[3] * v0[3])) + ((v1[0] * v1[0] + v1[1] * v1[1]) + (v1[2] * v1[2] + v1[3] * v1[3]));
                s += __shfl_xor(s, 16); s += __shfl_xor(s, 32); q += __shfl_xor(q, 16); q += __shfl_xor(q, 32);
                if (fq == 0) { unsafeAtomicAdd(vsum + row, s); unsafeAtomicAdd(vsq + row, q); } }
        }
    }
    __device__ __forceinline__ void operator()(const f32x4 (&acc)[2][2][4][2], const Unit& u, int wr, int wc, int fr, int fq) const {
        if (u.pn * 256 < 2 * CW) {
#pragma unroll
            for (int ai = 0; ai < 2; ++ai)
#pragma unroll
                for (int bj = 0; bj < 2; ++bj) quad(acc[ai][bj], u.pm * 256 + ai * 128, u.pn * 256 + bj * 128, wr, wc, fr, fq);
        } else {
#pragma unroll
            for (int ai = 0; ai < 2; ++ai)
#pragma unroll
                for (int m = 0; m < 4; ++m) { const int row = u.pm * 256 + ai * 128 + wr * 64 + fr + m * 16; const float rs = rsqrtf(ssq1[row] * (1.f / DM) + RMS_EPS); float s = 0.f, q = 0.f;
#pragma unroll
                    for (int bj = 0; bj < 2; ++bj) { const int cv = u.pn * 256 + bj * 128 + wc * 32 + 8 * fq - 2 * CW; const f32x4 v0 = acc[ai][bj][m][0] * rs, v1 = acc[ai][bj][m][1] * rs;
                        u32x4 w; w.x = cvtpk(v0[0], v0[1]); w.y = cvtpk(v0[2], v0[3]); w.z = cvtpk(v1[0], v1[1]); w.w = cvtpk(v1[2], v1[3]);
                        *(u32x4*)(UZV + (size_t)MT * CW + ((size_t)(cv >> 8) * MT + row) * 256 + (cv & 255)) = w;
                        s += ((v0[0] + v0[1]) + (v0[2] + v0[3])) + ((v1[0] + v1[1]) + (v1[2] + v1[3]));
                        q += ((v0[0] * v0[0] + v0[1] * v0[1]) + (v0[2] * v0[2] + v0[3] * v0[3])) + ((v1[0] * v1[0] + v1[1] * v1[1]) + (v1[2] * v1[2] + v1[3] * v1[3])); }
                    s += __shfl_xor(s, 16); s += __shfl_xor(s, 32); q += __shfl_xor(q, 16); q += __shfl_xor(q, 32);
                    if (fq == 0) { unsafeAtomicAdd(vsum + row, s); unsafeAtomicAdd(vsq + row, q); } }
        }
    }
};
struct Epi4 {
    static constexpr bool PERM = false, AFTER_DRAIN = false, ACC_INIT = true;
    const float* H1; float* out; float* ssq; bool pre;
    __device__ __forceinline__ void init(f32x4 (&acc)[2][2][4][2], const Unit& u, int wr, int wc, int fr, int fq) const {
#pragma unroll
        for (int ai = 0; ai < 2; ++ai)
#pragma unroll
            for (int m = 0; m < 4; ++m) { const int row = u.pm * 256 + ai * 128 + wr * 64 + m * 16 + fr;
#pragma unroll
                for (int bj = 0; bj < 2; ++bj)
#pragma unroll
                    for (int n = 0; n < 2; ++n) acc[ai][bj][m][n] = __builtin_nontemporal_load((const f32x4*)(H1 + (size_t)row * DM + u.pn * 256 + bj * 128 + wc * 32 + 4 * fq + n * 16)); }
    }
    __device__ __forceinline__ void quad(const f32x4 (&a)[4][2], int rowq, int colq, int wr, int wc, int fr, int fq) const {
        const int col0 = colq + wc * 32 + 4 * fq;
#pragma unroll
        for (int m = 0; m < 4; ++m) { const int row = rowq + wr * 64 + m * 16 + fr; float s = 0.f;
#pragma unroll
            for (int n = 0; n < 2; ++n) { const int c = col0 + n * 16; f32x4 hv = a[m][n]; if (!pre) hv += *(const f32x4*)(H1 + (size_t)row * DM + c);
                *(f32x4*)(out + (size_t)row * DM + c) = hv; s += (hv[0] * hv[0] + hv[1] * hv[1]) + (hv[2] * hv[2] + hv[3] * hv[3]); }
            s += __shfl_xor(s, 16); s += __shfl_xor(s, 32);
            if (fq == 0) unsafeAtomicAdd(ssq + row, s); }
    }
    EPI_TILE_OP()
};

template <class Epi, int KS = 1>
__device__ __forceinline__ void gemm_small_phase(PG8_LAS unsigned char* lds, const bf16_t* A, const bf16_t* Bt, int row_off, int Ms, int N, int K, const Epi& E, float* scr = nullptr, unsigned* cnt = nullptr) {
    const int tid = threadIdx.x, wid = __builtin_amdgcn_readfirstlane(tid >> 6), lane = tid & 63, wr = wid >> 2, wc = wid & 3, fr = lane & 15, fq = lane >> 4;
    unsigned voffA[2], voffB[2];
#pragma unroll
    for (int i = 0; i < 2; ++i) { int R, C; pg8::stage_rc(tid * 16 + i * 8192, R, C); const int Rb = Epi::PERM ? ((R & ~31) + pg8::perm32(R & 31)) : R;
        voffA[i] = (unsigned)(R * K + C) * 2u; voffB[i] = (unsigned)(Rb * K + C) * 2u; }
    const unsigned ldsw = (unsigned)wid * 1024u;
    const int aoff = pg8::lds_byte(wr * 64 + fr, fq * 8), boff = pg8::lds_byte(wc * 32 + fr, fq * 8);
    const int nMq = Ms / 128, nu = nMq * (N / 128), nt = K / 64 / KS;
#define GS_STAGE(slot, ga, gb) do { _Pragma("unroll") for (int _i = 0; _i < 2; ++_i) { \
        __builtin_amdgcn_global_load_lds((const unsigned*)((ga) + voffA[_i]), (PG8_LAS unsigned*)(lds + (slot) * 32768 + ldsw + _i * 8192), 16, 0, 0); \
        __builtin_amdgcn_global_load_lds((const unsigned*)((gb) + voffB[_i]), (PG8_LAS unsigned*)(lds + (slot) * 32768 + 16384 + ldsw + _i * 8192), 16, 0, 0); } } while (0)
    const int nNq = N / 128, xcd = blockIdx.x & 7, per = gridDim.x >> 3; (void)nu;
    if ((int)(blockIdx.x >> 3) < per)
    for (int loc = blockIdx.x >> 3; ; loc += per) {
        const int split = loc % KS, ul = loc / KS; const int pm = ul % nMq, pn = (ul / nMq) * 8 + xcd; if (pn >= nNq) break;
        const char* cA = (const char*)A + ((size_t)(row_off + pm * 128) * K + (size_t)split * (K / KS)) * 2; const char* cB = (const char*)Bt + ((size_t)(pn * 128) * K + (size_t)split * (K / KS)) * 2;
        f32x4 acc[4][2];
#pragma unroll
        for (int m = 0; m < 4; ++m) { acc[m][0] = (f32x4){0.f, 0.f, 0.f, 0.f}; acc[m][1] = (f32x4){0.f, 0.f, 0.f, 0.f}; }
        GS_STAGE(0, cA, cB); GS_STAGE(1, cA + 128, cB + 128); GS_STAGE(2, cA + 256, cB + 256);
        for (int t = 0; t < nt; ++t) {
            asm volatile("s_waitcnt vmcnt(8)" ::: "memory"); __builtin_amdgcn_s_barrier();
            { const int tn = (t + 3 < nt) ? t + 3 : t + 3 - nt; GS_STAGE((t + 3) & 3, cA + (size_t)tn * 128, cB + (size_t)tn * 128); }
            const int so = (t & 3) * 32768;
            bf16x8 At[4][2], Bf[2][2];
#pragma unroll
            for (int m = 0; m < 4; ++m)
#pragma unroll
                for (int k = 0; k < 2; ++k) At[m][k] = *(const PG8_LAS bf16x8*)(lds + so + aoff + m * 2048 + k * 1024);
#pragma unroll
            for (int n = 0; n < 2; ++n)
#pragma unroll
                for (int k = 0; k < 2; ++k) Bf[n][k] = *(const PG8_LAS bf16x8*)(lds + so + 16384 + boff + n * 2048 + k * 1024);
            asm volatile("s_waitcnt lgkmcnt(0)" ::: "memory"); __builtin_amdgcn_sched_barrier(0);
#pragma unroll
            for (int m = 0; m < 4; ++m)
#pragma unroll
                for (int n = 0; n < 2; ++n)
#pragma unroll
                    for (int k = 0; k < 2; ++k) acc[m][n] = __builtin_amdgcn_mfma_f32_16x16x32_bf16(Bf[n][k], At[m][k], acc[m][n], 0, 0, 0);
        }
        asm volatile("s_waitcnt vmcnt(0)" ::: "memory"); __builtin_amdgcn_s_barrier();
        if (KS > 1) {
            typedef unsigned long long u64;
            const int unit = pn * nMq + pm; u64* part = (u64*)scr + (size_t)unit * KS * 16 * 512 + tid;
#pragma unroll
            for (int j = 0; j < 16; ++j) { const f32x4 v = acc[j >> 2][(j >> 1) & 1]; const float lo = (j & 1) ? v[2] : v[0], hi2 = (j & 1) ? v[3] : v[1];
                __hip_atomic_store(part + (size_t)(split * 16 + j) * 512, ((u64)__float_as_uint(hi2) << 32) | (u64)__float_as_uint(lo), __ATOMIC_RELAXED, __HIP_MEMORY_SCOPE_AGENT); }
            asm volatile("s_waitcnt vmcnt(0)" ::: "memory"); __syncthreads();
            if (tid == 0) { const unsigned old = __hip_atomic_fetch_add(cnt + unit, 1u, __ATOMIC_RELAXED, __HIP_MEMORY_SCOPE_AGENT); *(PG8_LAS unsigned*)(lds + 131072) = old; }
            __syncthreads();
            const bool last = *(PG8_LAS unsigned*)(lds + 131072) == (unsigned)(KS - 1);
            __syncthreads();
            if (!last) continue;
            __builtin_amdgcn_fence(__ATOMIC_ACQUIRE, "agent");
#pragma unroll
            for (int j = 0; j < 16; ++j) { float lo = 0.f, hi2 = 0.f;
#pragma unroll
                for (int sp = 0; sp < KS; ++sp) { const u64 w = *(const u64*)(part + (size_t)(sp * 16 + j) * 512); lo += __uint_as_float((unsigned)w); hi2 += __uint_as_float((unsigned)(w >> 32)); }
                f32x4& v = acc[j >> 2][(j >> 1) & 1]; if (j & 1) { v[2] = lo; v[3] = hi2; } else { v[0] = lo; v[1] = hi2; } }
        }
        E.quad(acc, row_off + pm * 128, pn * 128, wr, wc, fr, fq);
    }
#undef GS_STAGE
}

#define KSWZ(row, colB) ((row) * 256 + ((colB) ^ (((row) & 7) << 4)))
__device__ __forceinline__ int crow(int r, int hi) { return (r & 3) + 8 * (r >> 2) + 4 * hi; }
__device__ __forceinline__ bf16x8 tobf8(f32x8 x) { u32x4 w = {cvtpk(x[0], x[1]), cvtpk(x[2], x[3]), cvtpk(x[4], x[5]), cvtpk(x[6], x[7])}; return *reinterpret_cast<bf16x8*>(&w); }
__device__ __forceinline__ f32x8 tof8(bf16x8 x) { f32x8 r;
#pragma unroll
    for (int i = 0; i < 8; ++i) r[i] = bf2f(x[i]); return r; }
__device__ __forceinline__ void qkt(f32x16& p0, f32x16& p1, const char* Ks, const char* Qs, int r32, int hi) {
#pragma unroll
    for (int d0 = 0; d0 < 8; ++d0) { const int cb = (d0 * 16 + hi * 8) * 2;
        const bf16x8 qv = *reinterpret_cast<const bf16x8*>(Qs + KSWZ(r32, cb));
        const bf16x8 b0 = *reinterpret_cast<const bf16x8*>(Ks + KSWZ(r32, cb));
        const bf16x8 b1 = *reinterpret_cast<const bf16x8*>(Ks + KSWZ(32 + r32, cb));
        p0 = __builtin_amdgcn_mfma_f32_32x32x16_bf16(b0, qv, p0, 0, 0, 0);
        p1 = __builtin_amdgcn_mfma_f32_32x32x16_bf16(b1, qv, p1, 0, 0, 0); }
}
__device__ __forceinline__ int v_st(int k, int c) { const int kk = (k & ~0xC) | ((k & 4) << 1) | ((k & 8) >> 1); return ((kk >> 3) * 4 + (c >> 5)) * 512 + ((kk & 7) * 32 + (c & 31)) * 2; }
__device__ __forceinline__ int v_rd_base(int lane) { return ((lane & 3) << 3) | (((lane >> 2) & 3) << 6) | (((lane >> 4) & 1) << 5) | (((lane >> 5) & 1) << 8); }
constexpr int v_rd_off(int d0, int ks, int half) { return d0 * 512 + ks * 4096 + half * 2048; }
template <int OFF> __device__ __forceinline__ s16x4 tr_read(int vb) { s16x4 r; asm volatile("ds_read_b64_tr_b16 %0, %1 offset:%2" : "=&v"(r) : "v"(vb), "i"(OFF) : "memory"); return r; }
template <int D0> __device__ __forceinline__ void pv_one(f32x16& od, int vb, bf16x8 pa0, bf16x8 pa1, bf16x8 pa2, bf16x8 pa3) {
    const s16x4 l0 = tr_read<v_rd_off(D0, 0, 0)>(vb), h0 = tr_read<v_rd_off(D0, 0, 1)>(vb), l1 = tr_read<v_rd_off(D0, 1, 0)>(vb), h1 = tr_read<v_rd_off(D0, 1, 1)>(vb);
    const s16x4 l2 = tr_read<v_rd_off(D0, 2, 0)>(vb), h2 = tr_read<v_rd_off(D0, 2, 1)>(vb), l3 = tr_read<v_rd_off(D0, 3, 0)>(vb), h3 = tr_read<v_rd_off(D0, 3, 1)>(vb);
    asm volatile("s_waitcnt lgkmcnt(0)" ::: "memory"); SBAR();
#define PKV(L, H) (bf16x8){L[0], L[1], L[2], L[3], H[0], H[1], H[2], H[3]}
    od = __builtin_amdgcn_mfma_f32_32x32x16_bf16(pa0, PKV(l0, h0), od, 0, 0, 0);
    od = __builtin_amdgcn_mfma_f32_32x32x16_bf16(pa1, PKV(l1, h1), od, 0, 0, 0);
    od = __builtin_amdgcn_mfma_f32_32x32x16_bf16(pa2, PKV(l2, h2), od, 0, 0, 0);
    od = __builtin_amdgcn_mfma_f32_32x32x16_bf16(pa3, PKV(l3, h3), od, 0, 0, 0);
#undef PKV
}
__device__ __forceinline__ void pv_d0(f32x16* o, int vb, bf16x8 pa0, bf16x8 pa1, bf16x8 pa2, bf16x8 pa3) {
    pv_one<0>(o[0], vb, pa0, pa1, pa2, pa3); pv_one<1>(o[1], vb, pa0, pa1, pa2, pa3); pv_one<2>(o[2], vb, pa0, pa1, pa2, pa3); pv_one<3>(o[3], vb, pa0, pa1, pa2, pa3);
}
#define PK4(P, BASE, OUT) do { unsigned a0_ = cvtpk(P[BASE + 0], P[BASE + 1]), a1_ = cvtpk(P[BASE + 2], P[BASE + 3]);   \
    unsigned b0_ = cvtpk(P[BASE + 4], P[BASE + 5]), b1_ = cvtpk(P[BASE + 6], P[BASE + 7]);                              \
    auto r0_ = __builtin_amdgcn_permlane32_swap(a0_, b0_, false, false); auto r1_ = __builtin_amdgcn_permlane32_swap(a1_, b1_, false, false); \
    u32x4 w_ = {r0_[0], r1_[0], r0_[1], r1_[1]}; OUT = *reinterpret_cast<bf16x8*>(&w_); } while (0)

constexpr int NSP = 2;
constexpr int AL_K = 0, AL_V = 32768, AL_BIAS = 65536, AL_WS = 73728, AL_SCAN = 75776, AL_Q = 77824;

template <int MODE, bool SAMPLE>
__device__ __forceinline__ void attn_unit(const Params& p, char* lds, int b, int h, int qb) {
    constexpr int var = 0;
    const int tid = threadIdx.x, wid = __builtin_amdgcn_readfirstlane(tid >> 6), lane = tid & 63, r32 = lane & 31, hi = lane >> 5;
    char* K_lds = lds + AL_K; char* V_lds = lds + AL_V; float* biasL = (float*)(lds + AL_BIAS); float* wsc = (float*)(lds + AL_WS) + wid * 64; float* scanL = (float*)(lds + AL_SCAN);
    const bf16_t* P1 = (const bf16_t*)(p.ws + WS_P1);
    const size_t HB = (size_t)MT * 128;
    const bf16_t* P1q = P1 + (size_t)((MODE ? 32 : 0) + h) * HB;
    const size_t qrow = SAMPLE ? (size_t)(MP + b * TS + (r32 & 15)) : (size_t)(b * SEQ + qb * 256 + wid * 32 + r32);
    const bf16_t* Qw = P1q + qrow * 128 + hi * 8;
    char* Qs = lds + AL_Q + wid * 8192;
#pragma unroll
    for (int d0 = 0; d0 < 8; ++d0) *reinterpret_cast<bf16x8*>(Qs + KSWZ(r32, (d0 * 16 + hi * 8) * 2)) = *reinterpret_cast<const bf16x8*>(Qw + d0 * 16);
    const int qw0 = SAMPLE ? PAST : qb * 256 + wid * 32;
    const int qpos = SAMPLE ? PAST + (r32 & 15) : qw0 + r32;
    const int jd = SAMPLE ? 16 : (qw0 >> 6);
    const int jfirst = SAMPLE ? 16 : qb * 4 + 3;
    const bool wact = SAMPLE ? (wid == 0) : true;
    const int sr = tid >> 4, sc = (tid & 15) * 8;
    const int vst0 = v_st(sr, sc), vst1 = v_st(32 + sr, sc), kst0 = KSWZ(sr, sc * 2), kst1 = KSWZ(32 + sr, sc * 2);
    const int vb0 = (int)(uintptr_t)V_lds + v_rd_base(lane);
    struct StgT { bf16x8 k0, k1, v0, v1; f32x8 fk0, fk1, fv0, fv1; } stg2[SAMPLE ? 1 : NSP];
    const float* cK = MODE ? p.csk : p.cfk; const float* cV = MODE ? p.csv : p.cfv;
#define LOADT(j, S_) do { if (!SAMPLE) { const bf16_t* kb_ = P1q + 8 * HB + (size_t)(b * SEQ + (j) * 64) * 128 + sc;                               \
        S_.k0 = *(const bf16x8*)(kb_ + (size_t)sr * 128); S_.k1 = *(const bf16x8*)(kb_ + (size_t)(sr + 32) * 128);                                       \
        S_.v0 = *(const bf16x8*)(kb_ + 8 * HB + (size_t)sr * 128); S_.v1 = *(const bf16x8*)(kb_ + 8 * HB + (size_t)(sr + 32) * 128); }                       \
    else if ((j) < 16) { const size_t o_ = (((size_t)b * PAST + (j) * 64) * NH + h) * HD + sc;                                                        \
        S_.fk0 = __builtin_nontemporal_load((const f32x8*)(cK + o_ + (size_t)sr * 1024)); S_.fk1 = __builtin_nontemporal_load((const f32x8*)(cK + o_ + (size_t)(sr + 32) * 1024));   \
        S_.fv0 = __builtin_nontemporal_load((const f32x8*)(cV + o_ + (size_t)sr * 1024)); S_.fv1 = __builtin_nontemporal_load((const f32x8*)(cV + o_ + (size_t)(sr + 32) * 1024)); }   \
    else { const bf16_t* kb_ = P1q + 8 * HB + (size_t)(MP + b * TS) * 128 + sc; const int ra_ = sr < 15 ? sr : 15;                                   \
        S_.fk0 = tof8(*(const bf16x8*)(kb_ + (size_t)ra_ * 128)); S_.fk1 = tof8(*(const bf16x8*)(kb_ + (size_t)15 * 128));                               \
        S_.fv0 = tof8(*(const bf16x8*)(kb_ + 8 * HB + (size_t)ra_ * 128)); S_.fv1 = tof8(*(const bf16x8*)(kb_ + 8 * HB + (size_t)15 * 128)); } } while (0)
#define WRITET(buf, S_) do { if (!SAMPLE) { *(bf16x8*)(K_lds + (buf) * 16384 + kst0) = S_.k0; *(bf16x8*)(K_lds + (buf) * 16384 + kst1) = S_.k1;       \
        *(bf16x8*)(V_lds + (buf) * 16384 + vst0) = S_.v0; *(bf16x8*)(V_lds + (buf) * 16384 + vst1) = S_.v1; }                                          \
    else { *(bf16x8*)(K_lds + (buf) * 16384 + kst0) = tobf8(S_.fk0); *(bf16x8*)(K_lds + (buf) * 16384 + kst1) = tobf8(S_.fk1);                         \
        *(bf16x8*)(V_lds + (buf) * 16384 + vst0) = tobf8(S_.fv0); *(bf16x8*)(V_lds + (buf) * 16384 + vst1) = tobf8(S_.fv1); } } while (0)
    f32x16 o[4] = {};
    float m_reg = -1e30f, l_reg = 0.f, carry = 1.f;
    constexpr int NS = SAMPLE ? 1 : NSP;
    constexpr int PAR0 = SAMPLE ? 0 : 1;
    LOADT(jfirst, stg2[NS == 2 ? PAR0 : 0]); if (NS == 2) LOADT(jfirst - 1, stg2[NS == 2 ? (PAR0 ^ 1) : 0]);
    if (MODE == 0) {
        float v[4];
#pragma unroll
        for (int i = 0; i < 4; ++i) { const int pos = 4 * tid + i; float x = 0.f;
            if (SAMPLE) { if (pos < PAST) x = p.cflogf[((size_t)b * PAST + pos) * NH + h]; else if (pos < PAST + TS) x = p.out[O_FLS + ((size_t)b * TS + pos - PAST) * NH + h]; }
            else { if (pos < 256 * (qb + 1)) x = p.out[O_FLP + ((size_t)b * SEQ + pos) * NH + h]; }
            v[i] = x; }
        const float s0 = v[0], s1 = s0 + v[1], s2 = s1 + v[2], s3 = s2 + v[3]; float incl = s3;
#pragma unroll
        for (int o = 1; o < 64; o <<= 1) { const float t = __shfl_up(incl, o); if (lane >= o) incl += t; }
        if (lane == 63) scanL[wid] = incl;
        __syncthreads();
        float base = incl - s3;
#pragma unroll
        for (int w = 0; w < 8; ++w) if (w < wid) base += scanL[w];
        f32x4 bv = {-(base + s0) * LOG2E, -(base + s1) * LOG2E, -(base + s2) * LOG2E, -(base + s3) * LOG2E};
        *(f32x4*)(biasL + 4 * tid) = bv;
        __syncthreads();
    }
    for (int jj = jfirst >> 1; jj >= 0; --jj) {
#pragma unroll
      for (int par = 1; par >= 0; --par) {
        const int j = 2 * jj + par;
        if (j > jfirst) continue;
        const int buf = par;
        WRITET(buf, stg2[NS == 2 ? par : 0]);
        if (j >= NS) LOADT(j - NS, stg2[NS == 2 ? par : 0]);
        __syncthreads();
        if (wact && j <= jd && var < 2) {
            const char* Kt = K_lds + buf * 16384; const int vb = vb0 + buf * 16384;
            f32x16 p0, p1; bf16x8 pa0, pa1, pa2, pa3;
            if (MODE == 0) {
                const float* bt = biasL + j * 64 + 4 * hi;
#pragma unroll
                for (int g = 0; g < 4; ++g) { const f32x4 a = *(const f32x4*)(bt + 8 * g), c = *(const f32x4*)(bt + 32 + 8 * g);
#pragma unroll
                    for (int i = 0; i < 4; ++i) { p0[4 * g + i] = a[i]; p1[4 * g + i] = c[i]; } }
                qkt(p0, p1, Kt, Qs, r32, hi);
                if (j == jd) {
#pragma unroll
                    for (int r = 0; r < 16; ++r) { const int kp = j * 64 + crow(r, hi); if (kp > qpos) p0[r] = -1e30f; if (kp + 32 > qpos) p1[r] = -1e30f; } }
                float pmax = p0[0];
#pragma unroll
                for (int r = 1; r < 16; ++r) pmax = fmaxf(pmax, p0[r]);
#pragma unroll
                for (int r = 0; r < 16; ++r) pmax = fmaxf(pmax, p1[r]);
                { auto rr = __builtin_amdgcn_permlane32_swap(__float_as_uint(pmax), __float_as_uint(pmax), false, false); pmax = fmaxf(__uint_as_float(rr[0]), __uint_as_float(rr[1])); }
                float alpha = 1.f;
                if (!__all(pmax - m_reg <= 8.f)) { const float mn = fmaxf(m_reg, pmax); alpha = __builtin_amdgcn_exp2f(m_reg - mn); m_reg = mn; }
                float ps = 0.f;
#pragma unroll
                for (int r = 0; r < 16; ++r) { p0[r] = __builtin_amdgcn_exp2f(p0[r] - m_reg); p1[r] = __builtin_amdgcn_exp2f(p1[r] - m_reg); ps += p0[r] + p1[r]; }
                { auto rr = __builtin_amdgcn_permlane32_swap(__float_as_uint(ps), __float_as_uint(ps), false, false); ps = __uint_as_float(rr[0]) + __uint_as_float(rr[1]); }
                l_reg = l_reg * alpha + ps;
                if (__any(alpha < 1.f)) { if (hi == 0) wsc[r32] = alpha; asm volatile("s_waitcnt lgkmcnt(0)" ::: "memory");
#pragma unroll
                    for (int d = 0; d < 4; ++d)
#pragma unroll
                        for (int r = 0; r < 16; ++r) o[d][r] *= wsc[crow(r, hi)]; }
            } else {
                p0 = f32x16{}; p1 = f32x16{};
                qkt(p0, p1, Kt, Qs, r32, hi);
                if (j == jd) {
#pragma unroll
                    for (int r = 0; r < 16; ++r) { const int kp = j * 64 + crow(r, hi); if (kp >= qpos) p0[r] = -1e30f; if (kp + 32 >= qpos) p1[r] = -1e30f; } }
                f32x16 s0, s1;
#pragma unroll
                for (int r = 0; r < 16; ++r) { p0[r] = __builtin_amdgcn_exp2f(fminf(p0[r], 100.f)); p1[r] = __builtin_amdgcn_exp2f(fminf(p1[r], 100.f));
                    s0[r] = __builtin_amdgcn_rcpf(1.f + p0[r]); s1[r] = __builtin_amdgcn_rcpf(1.f + p1[r]); }
                float run = carry, bs[8];
#pragma unroll
                for (int i = 7; i >= 0; --i) { const f32x16& S = (i >= 4) ? s1 : s0; const int rb = 4 * (i & 3);
                    const float gs = (S[rb] * S[rb + 1]) * (S[rb + 2] * S[rb + 3]);
                    auto rr = __builtin_amdgcn_permlane32_swap(__float_as_uint(gs), __float_as_uint(gs), false, false);
                    const float glo = __uint_as_float(rr[0]), ghi = __uint_as_float(rr[1]);
                    const float exH = run; run *= ghi; const float exL = run; run *= glo;
                    bs[i] = hi ? exH : exL; }
                carry = run;
#pragma unroll
                for (int i = 0; i < 8; ++i) { f32x16& S = (i >= 4) ? s1 : s0; f32x16& Z = (i >= 4) ? p1 : p0; const int rb = 4 * (i & 3);
                    const float i3 = bs[i] * S[rb + 3], i2 = i3 * S[rb + 2], i1 = i2 * S[rb + 1], i0 = i1 * S[rb];
                    Z[rb + 3] *= i3; Z[rb + 2] *= i2; Z[rb + 1] *= i1; Z[rb] *= i0; }
            }
            PK4(p0, 0, pa0); PK4(p0, 8, pa1); PK4(p1, 0, pa2); PK4(p1, 8, pa3);
            pv_d0(o, vb, pa0, pa1, pa2, pa3);
        }
      }
    }
    if (wact && var < 1) {
        bf16_t* MIX = (bf16_t*)(p.ws + (var == 0 ? WS_MIX : WS_ACT));
        const size_t rbase = SAMPLE ? (size_t)(MP + b * TS) : (size_t)(b * SEQ + qb * 256 + wid * 32);
        constexpr int NIT = SAMPLE ? 4 : 8; const int er = lane >> 4, ec = (lane & 15) * 8;
        float rli[16];
        if (MODE == 0) { if (hi == 0) wsc[32 + r32] = l_reg; asm volatile("s_waitcnt lgkmcnt(0)" ::: "memory");
#pragma unroll
            for (int r = 0; r < 16; ++r) rli[r] = __builtin_amdgcn_rcpf(wsc[32 + crow(r, hi)]); }
#pragma unroll
        for (int r = 0; r < 16; ++r) { const int orow = crow(r, hi);
            if (!SAMPLE || orow < TS) {
#pragma unroll
                for (int d0 = 0; d0 < 4; ++d0) { float ov = o[d0][r]; if (MODE == 0) ov *= rli[r];
                    const unsigned pk = cvtpk(ov, 0.f); *(bf16_t*)(Qs + orow * 256 + (d0 * 32 + r32) * 2) = (bf16_t)(pk & 0xffffu); } } }
        asm volatile("s_waitcnt lgkmcnt(0)" ::: "memory");
        bf16x8 gt[NIT];
#pragma unroll
        for (int it = 0; it < NIT; ++it) gt[it] = __builtin_nontemporal_load((const bf16x8*)(P1q + 24 * HB + (rbase + it * 4 + er) * 128 + ec));
#pragma unroll
        for (int it = 0; it < NIT; ++it) { const int row = it * 4 + er; const bf16x8 mx = *(const bf16x8*)(Qs + row * 256 + ec * 2); f32x8 y;
#pragma unroll
            for (int i = 0; i < 8; ++i) y[i] = bf2f(mx[i]) * silu_fast(bf2f(gt[it][i]));
            *(bf16x8*)(MIX + (rbase + row) * DM + MODE * 1024 + h * HD + ec) = tobf8(y); }
    }
    __syncthreads();
#undef LOADT
#undef WRITET
}

__device__ __forceinline__ void attn_phase(const Params& p, char* lds) {
    const int G = gridDim.x;
    if ((blockIdx.x >> 3) & 1) {
        for (int u = blockIdx.x; u < 256; u += G) { attn_unit<0, true>(p, lds, u >> 3, u & 7, 0); attn_unit<1, true>(p, lds, u >> 3, u & 7, 0); }
        for (int u = blockIdx.x; u < 256; u += G) { const int bh = u & 31, i = u >> 5; attn_unit<0, false>(p, lds, bh >> 3, bh & 7, i); attn_unit<1, false>(p, lds, bh >> 3, bh & 7, 7 - i); }
    } else {
        for (int u = blockIdx.x; u < 256; u += G) { const int bh = u & 31, i = u >> 5; attn_unit<0, false>(p, lds, bh >> 3, bh & 7, i); attn_unit<1, false>(p, lds, bh >> 3, bh & 7, 7 - i); }
        for (int u = blockIdx.x; u < 256; u += G) { attn_unit<0, true>(p, lds, u >> 3, u & 7, 0); attn_unit<1, true>(p, lds, u >> 3, u & 7, 0); }
    }
}

__device__ __forceinline__ void spatial_phase(const Params& p, char* lds) {
    const int tid = threadIdx.x, wid = __builtin_amdgcn_readfirstlane(tid >> 6), lane = tid & 63, r32 = lane & 31, hi = lane >> 5;
    const bf16_t* UVZ = (const bf16_t*)(p.ws + WS_UVZ); bf16_t* ACT = (bf16_t*)(p.ws + WS_ACT);
    const float* st = (const float*)(p.ws + WS_STAT);
    const int sr = tid >> 4, sc = (tid & 15) * 8; const int tb = wid & 3, ch = wid >> 2;
    char* stg = lds + 65536 + wid * 8192;
    const int er = lane >> 4, ec = (lane & 15) * 8;
    const int t = 32 * tb + r32;
    bf16x8 raw[8]; float mu_[4], rs_[4]; bf16x8 pa[2][4]; int g_loaded = -1;
    float bsp_[16];
#define SP_DECODE(u_, samp_, g_, cidx_, rbase_, nrows_) const bool samp_ = (u_) >= 1024; const int g_ = (u_) & 15, cidx_ = samp_ ? (((u_) - 1024) >> 4) : ((u_) >> 4); \
        const size_t rbase_ = samp_ ? (size_t)(MP + cidx_ * TS) : (size_t)cidx_ * CCH; const int nrows_ = samp_ ? TS : CCH;
#define SP_PREFETCH(u_) do { SP_DECODE(u_, samp_, g_, cidx_, rbase_, nrows_) (void)cidx_;                                                              \
        _Pragma("unroll") for (int q = 0; q < 4; ++q) _Pragma("unroll") for (int hf = 0; hf < 2; ++hf) { const int s = (q >> 1) * 64 + sr + 32 * hf; raw[q * 2 + hf] = bf16x8{};   \
            if (s < nrows_) raw[q * 2 + hf] = __builtin_nontemporal_load((const bf16x8*)(UVZ + (size_t)MT * CW + ((size_t)g_ * MT + rbase_ + s) * 256 + (q & 1) * 128 + sc)); }                          \
        _Pragma("unroll") for (int k4 = 0; k4 < 4; ++k4) { const int s = (k4 >> 1) * 64 + sr + 32 * (k4 & 1); mu_[k4] = 0.f; rs_[k4] = 0.f;             \
            if (s < nrows_) { const size_t row = rbase_ + s; const float mu = st[ST_VSUM + row] * (1.f / CW); const float var = fmaxf(st[ST_VSQ + row] * (1.f / CW) - mu * mu, 0.f); mu_[k4] = mu; rs_[k4] = rsqrtf(var + LN_EPS); } } } while (0)
    int u = blockIdx.x;
    if (u < 1536) SP_PREFETCH(u);
    for (; u < 1536; u += gridDim.x) {
        SP_DECODE(u, samp, g, cidx, rbase, nrows)
        const bool act = samp ? (tb == 0) : true; const int nit = samp ? 4 : 8;
        if (g != g_loaded) { g_loaded = g;
#pragma unroll
            for (int st_ = 0; st_ < 2; ++st_)
#pragma unroll
                for (int ks = 0; ks < 4; ++ks) { const int s0 = 64 * st_ + 16 * ks + 8 * hi; const float* wp = p.w_sp + ((size_t)g * CCH + t) * CCH + s0;
                    const f32x4 a = *(const f32x4*)wp, c = *(const f32x4*)(wp + 4); f32x8 y;
#pragma unroll
                    for (int i = 0; i < 4; ++i) { y[i] = (s0 + i <= t) ? a[i] : 0.f; y[4 + i] = (s0 + 4 + i <= t) ? c[i] : 0.f; }
                    pa[st_][ks] = tobf8(y); }
#pragma unroll
            for (int r = 0; r < 16; ++r) bsp_[r] = p.b_sp[g * CCH + 32 * tb + crow(r, hi)]; }
        bf16x8 uu[8];
        if (act) {
#pragma unroll
            for (int it = 0; it < 8; ++it) if (it < nit) { const size_t row = rbase + 32 * tb + it * 4 + er; uu[it] = __builtin_nontemporal_load((const bf16x8*)(UVZ + ((size_t)g * MT + row) * 256 + ch * 128 + ec)); } }
#pragma unroll
        for (int q = 0; q < 4; ++q) { const int st_ = q >> 1, ch_ = q & 1; if (samp && st_ == 1) continue;
#pragma unroll
            for (int hf = 0; hf < 2; ++hf) { const int k = sr + 32 * hf, s = st_ * 64 + k; const int cc = ch_ * 128 + sc;
                bf16x8 w = {};
                if (s < nrows) { const float mu = mu_[st_ * 2 + hf], rs = rs_[st_ * 2 + hf];
                    const bf16x8 rw = raw[q * 2 + hf];
                    const f32x4 g0 = *(const f32x4*)(p.ln_g + g * GD + cc), g1 = *(const f32x4*)(p.ln_g + g * GD + cc + 4), b0 = *(const f32x4*)(p.ln_b + g * GD + cc), b1 = *(const f32x4*)(p.ln_b + g * GD + cc + 4);
                    f32x8 y;
#pragma unroll
                    for (int i = 0; i < 4; ++i) { y[i] = (bf2f(rw[i]) - mu) * rs * g0[i] + b0[i]; y[4 + i] = (bf2f(rw[4 + i]) - mu) * rs * g1[i] + b1[i]; }
                    if (samp) { float* d = p.out + O_SGV + (size_t)(cidx * TS + s) * CW + g * GD + cc; __builtin_nontemporal_store((f32x4){y[0], y[1], y[2], y[3]}, (f32x4*)d); __builtin_nontemporal_store((f32x4){y[4], y[5], y[6], y[7]}, (f32x4*)(d + 4)); }
                    w = tobf8(y); }
                *(bf16x8*)(lds + q * 16384 + v_st(k, sc)) = w; } }
        __syncthreads();
        if (u + (int)gridDim.x < 1536) SP_PREFETCH(u + (int)gridDim.x);
        if (act) {
            f32x16 o[4] = {};
            const int nst = (!samp && tb >= 2) ? 2 : 1;
            { const int vb = (int)(uintptr_t)(lds + ch * 16384) + v_rd_base(lane); pv_d0(o, vb, pa[0][0], pa[0][1], pa[0][2], pa[0][3]); }
            if (nst == 2) { const int vb = (int)(uintptr_t)(lds + (2 + ch) * 16384) + v_rd_base(lane); pv_d0(o, vb, pa[1][0], pa[1][1], pa[1][2], pa[1][3]); }
#pragma unroll
            for (int r = 0; r < 16; ++r) { const int tl = crow(r, hi); const float bsp = bsp_[r];
#pragma unroll
                for (int d0 = 0; d0 < 4; ++d0) { const unsigned pk = cvtpk(o[d0][r] + bsp, 0.f); *(bf16_t*)(stg + tl * 256 + (d0 * 32 + r32) * 2) = (bf16_t)(pk & 0xffffu); } }
            asm volatile("s_waitcnt lgkmcnt(0)" ::: "memory");
#pragma unroll
            for (int it = 0; it < 8; ++it) if (it < nit) { const int tl = it * 4 + er; const size_t row = rbase + 32 * tb + tl; const int col = g * GD + ch * 128 + ec;
                const bf16x8 mx = *(const bf16x8*)(stg + tl * 256 + ec * 2); f32x8 y;
#pragma unroll
                for (int i = 0; i < 8; ++i) y[i] = bf2f(uu[it][i]) * bf2f(mx[i]);
                *(bf16x8*)(ACT + row * CW + col) = tobf8(y); }
        }
        __syncthreads();
    }
#undef SP_DECODE
#undef SP_PREFETCH
}

__device__ __forceinline__ unsigned f2bf(float f) { unsigned u = __builtin_bit_cast(unsigned, f); return (u + 0x7fffu + ((u >> 16) & 1u)) >> 16; }
__device__ __forceinline__ unsigned pk2(float lo, float hi) { return f2bf(lo) | (f2bf(hi) << 16); }
constexpr int P0_I0 = (DM / 64) * (N1 / 32), P0_I1 = (DM / 64) * (DM / 32), P0_I2 = (DM / 64) * (N3 / 32), P0_I3 = (CW / 64) * (DM / 32), P0_NIT = P0_I0 + P0_I1 + P0_I2 + P0_I3;
__device__ __forceinline__ void p0_item_decode(const Params& p, int it, const float*& W, int& ld, int& nblk, int& K, bf16_t*& WT, bool& uzmap, int& r) {
    r = it; uzmap = false;
    if (r < P0_I0) { W = p.w_in0; ld = LDW0; nblk = N1 / 32; K = DM; WT = (bf16_t*)(p.ws + WS_W0T); return; } r -= P0_I0;
    if (r < P0_I1) { W = p.w_out0; ld = DM; nblk = DM / 32; K = DM; WT = (bf16_t*)(p.ws + WS_WO0T); return; } r -= P0_I1;
    if (r < P0_I2) { W = p.w_in1; ld = N3; nblk = N3 / 32; K = DM; WT = (bf16_t*)(p.ws + WS_W1T); uzmap = true; return; } r -= P0_I2;
    W = p.w_out1; ld = DM; nblk = DM / 32; K = CW; WT = (bf16_t*)(p.ws + WS_WO1T);
}
__device__ __forceinline__ void p0_item_load(const Params& p, int it, float (&t)[32], int lane) {
    const float* W; int ld, nblk, K, r; bf16_t* WT; bool uz; p0_item_decode(p, it, W, ld, nblk, K, WT, uz, r);
    const int kb = r / nblk, nb = r % nblk, k0 = 64 * kb, n0 = 32 * nb;
    const float* src = W + (size_t)(k0 + (lane >> 5)) * ld + n0 + (lane & 31);
#pragma unroll
    for (int i = 0; i < 32; ++i) t[i] = __builtin_nontemporal_load(src + (size_t)(2 * i) * ld);
}
__device__ __forceinline__ void p0_item_store(const Params& p, int it, const float (&t)[32], LAS float* scr, int lane) {
    const float* W; int ld, nblk, K, r; bf16_t* WT; bool uz; p0_item_decode(p, it, W, ld, nblk, K, WT, uz, r);
    const int kb = r / nblk, nb = r % nblk, k0 = 64 * kb, n0 = 32 * nb;
#pragma unroll
    for (int i = 0; i < 32; ++i) { const int kk = 2 * i + (lane >> 5); scr[kk * 33 + (lane & 31)] = t[i]; }
    asm volatile("s_waitcnt lgkmcnt(0)" ::: "memory");
    const int c = lane & 7;
#pragma unroll
    for (int j = 0; j < 4; ++j) { const int n = (lane >> 3) + 8 * j; const LAS float* s = scr + (8 * c) * 33 + n;
        u32x4 o; o.x = pk2(s[0 * 33], s[1 * 33]); o.y = pk2(s[2 * 33], s[3 * 33]); o.z = pk2(s[4 * 33], s[5 * 33]); o.w = pk2(s[6 * 33], s[7 * 33]);
        int nd = n0 + n;
        if (uz) { const int cc = nd & (CW - 1); nd = nd < CW ? 8 * (cc >> 2) + (cc & 3) : (nd < 2 * CW ? 2 * CW + cc : 8 * (cc >> 2) + 4 + (cc & 3)); }
        u32x4* dp = (u32x4*)(WT + (size_t)nd * K + k0 + 8 * c);
        if (it < P0_I0) *dp = o; else __builtin_nontemporal_store(o, dp); }
    asm volatile("s_waitcnt lgkmcnt(0)" ::: "memory");
}
__device__ __forceinline__ float log_sigmoid_f(float x) { return fminf(x, 0.f) - log1pf(expf(-fabsf(x))); }

__device__ __forceinline__ void p0_convert_items(const Params& p, LAS unsigned char* lds, int it_lo, int it_hi) {
    const int tid = threadIdx.x, wid = __builtin_amdgcn_readfirstlane(tid >> 6), lane = tid & 63;
    const int gw = blockIdx.x * 8 + wid, NGW = gridDim.x * 8;
    LAS float* scr = (LAS float*)(lds + wid * 8448);
    float ta[32], tb[32]; int it = it_lo + gw;
    if (it < it_hi) { p0_item_load(p, it, ta, lane);
        for (;;) { const int it2 = it + NGW; const bool h2 = it2 < it_hi; if (h2) p0_item_load(p, it2, tb, lane);
            p0_item_store(p, it, ta, scr, lane); if (!h2) break;
            const int it3 = it2 + NGW; const bool h3 = it3 < it_hi; if (h3) p0_item_load(p, it3, ta, lane);
            p0_item_store(p, it2, tb, scr, lane); if (!h3) break;
            it = it3; } }
    __syncthreads();
}
__device__ __forceinline__ void prologue_phase(const Params& p, unsigned char* ldsg) {
    const int tid = threadIdx.x, wid = __builtin_amdgcn_readfirstlane(tid >> 6), lane = tid & 63;
    const int gw = blockIdx.x * 8 + wid, NGW = gridDim.x * 8;
    LAS unsigned char* lds = (LAS unsigned char*)ldsg;
    { float* st = (float*)(p.ws + WS_STAT); for (int i = blockIdx.x * 512 + tid; i < 65536; i += gridDim.x * 512) st[i] = 0.f; }
    LAS float* wf = (LAS float*)(lds + 67584);
    float wv[32];
#pragma unroll
    for (int k = 0; k < 32; ++k) { const int i = tid + 512 * k; wv[k] = p.w_in0[(size_t)(i >> 3) * LDW0 + N1 + (i & 7)]; }
    p0_convert_items(p, lds, 0, P0_I0);
#pragma unroll
    for (int k = 0; k < 32; ++k) { const int i = tid + 512 * k; wf[(i >> 3) * 8 + ((i >> 5) << 2) + (i & 7)] = wv[k]; }
    __syncthreads();
    bf16_t* XN = (bf16_t*)(p.ws + WS_XN);
#define ROW_LOAD(m_, V_) do { const float* xr_ = (m_) < MP ? p.x_prompt + (size_t)(m_) * DM : p.x_sample + (size_t)((m_) - MP) * DM;                    \
        _Pragma("unroll") for (int j = 0; j < 8; ++j) V_[j] = __builtin_nontemporal_load((const f32x4*)(xr_ + 256 * j + 4 * lane)); } while (0)
#define ROW_PROC(m_, V_) do { float s = 0.f;                                                                                                            \
        _Pragma("unroll") for (int j = 0; j < 8; ++j) s += (V_[j][0] * V_[j][0] + V_[j][1] * V_[j][1]) + (V_[j][2] * V_[j][2] + V_[j][3] * V_[j][3]);      \
        const float rstd = rsqrtf(wave_sum(s) * (1.f / DM) + RMS_EPS);                                                                                  \
        float fa[8] = {0.f, 0.f, 0.f, 0.f, 0.f, 0.f, 0.f, 0.f};                                                                                          \
        _Pragma("unroll") for (int j = 0; j < 8; ++j) { const f32x4 gv = *(const f32x4*)(p.norm0_g + 256 * j + 4 * lane); const f32x4 hv = V_[j] * rstd * gv; \
            u32x2 w; w.x = cvtpk(hv[0], hv[1]); w.y = cvtpk(hv[2], hv[3]); *(u32x2*)(XN + (size_t)(m_) * DM + 256 * j + 4 * lane) = w;                    \
            _Pragma("unroll") for (int i = 0; i < 4; ++i) { const LAS f32x4* wp = (const LAS f32x4*)(wf + (256 * j + 4 * lane + i) * 8 + (64 * j + lane) * 4); const f32x4 w0 = wp[0], w1 = wp[1]; \
                fa[0] += hv[i] * w0[0]; fa[1] += hv[i] * w0[1]; fa[2] += hv[i] * w0[2]; fa[3] += hv[i] * w0[3];                                          \
                fa[4] += hv[i] * w1[0]; fa[5] += hv[i] * w1[1]; fa[6] += hv[i] * w1[2]; fa[7] += hv[i] * w1[3]; } }                                      \
        float mine = 0.f;                                                                                                                                \
        _Pragma("unroll") for (int c = 0; c < 8; ++c) { const float t = wave_sum(fa[c]); if (lane == c) mine = t; }                                      \
        if (lane < 8) { const float lf = log_sigmoid_f(mine + p.b_forget[lane]);                                                                         \
            if ((m_) < MP) p.out[O_FLP + (size_t)(m_) * 8 + lane] = lf; else p.out[O_FLS + (size_t)((m_) - MP) * 8 + lane] = lf; } } while (0)
    { f32x4 va[8], vb[8]; int m = gw;
        if (m < MT) { ROW_LOAD(m, va);
            for (;;) { const int m2 = m + NGW; const bool h2 = m2 < MT; if (h2) ROW_LOAD(m2, vb);
                ROW_PROC(m, va); if (!h2) break;
                const int m3 = m2 + NGW; const bool h3 = m3 < MT; if (h3) ROW_LOAD(m3, va);
                ROW_PROC(m2, vb); if (!h3) break;
                m = m3; } } }
#undef ROW_LOAD
#undef ROW_PROC
    __syncthreads();
}

__device__ __forceinline__ void final_phase(const Params& p) {
    const int tid = threadIdx.x, wid = tid >> 6, lane = tid & 63; const int gw = blockIdx.x * 8 + wid, NGW = gridDim.x * 8;
    const float* ssq2 = (const float*)(p.ws + WS_STAT) + ST_SSQ2;
    constexpr int RPW = 5;
    for (int m0 = gw; m0 < MT; m0 += RPW * NGW) {
        f32x4 v[RPW][8]; float rs[RPW];
#pragma unroll
        for (int k = 0; k < RPW; ++k) { const int m = m0 + k * NGW; rs[k] = 0.f;
            if (m < MT) { rs[k] = ssq2[m]; const float* yr = p.out + (size_t)m * DM;
#pragma unroll
                for (int j = 0; j < 8; ++j) v[k][j] = __builtin_nontemporal_load((const f32x4*)(yr + 256 * j + 4 * lane)); } }
        f32x4 gv[8];
#pragma unroll
        for (int j = 0; j < 8; ++j) gv[j] = *(const f32x4*)(p.final_g + 256 * j + 4 * lane);
#pragma unroll
        for (int k = 0; k < RPW; ++k) { const int m = m0 + k * NGW;
            if (m < MT) { const float r = rsqrtf(rs[k] * (1.f / DM) + RMS_EPS); float* yr = p.out + (size_t)m * DM;
#pragma unroll
                for (int j = 0; j < 8; ++j) __builtin_nontemporal_store(v[k][j] * r * gv[j], (f32x4*)(yr + 256 * j + 4 * lane)); } }
    }
}

#define RLX_AGENT __ATOMIC_RELAXED, __HIP_MEMORY_SCOPE_AGENT
#define LDS_WAIT() asm volatile("s_waitcnt lgkmcnt(0)" ::: "memory")
#define VM_WAIT() asm volatile("s_waitcnt vmcnt(0)" ::: "memory")
__device__ __forceinline__ unsigned long long rt() { return __builtin_amdgcn_s_memrealtime(); }
#define XB_TMO      128
#define XB_XCNT(j)  (256  + 64 * (j))
#define XB_XSUB(j)  (1280 + 64 * (j))
#define XB_XGEN(j)  (2304 + 64 * (j))
#define XB_TOP      3328
#define XB_TOPGEN   3392
#define XCD_BAR_WORDS 3456
#define XB_SPIN_CAP (1u << 18)

__device__ __forceinline__ unsigned xb_ld(unsigned* p)              { return __hip_atomic_load(p, __ATOMIC_RELAXED, __HIP_MEMORY_SCOPE_AGENT); }
__device__ __forceinline__ unsigned xb_add(unsigned* p, unsigned v) { return __hip_atomic_fetch_add(p, v, __ATOMIC_RELAXED, __HIP_MEMORY_SCOPE_AGENT); }
__device__ __forceinline__ unsigned xb_xcc_id() { return (unsigned)__builtin_amdgcn_s_getreg((3 << 11) | 20) & 0xFu; }
#define XB_SPIN(cond, bar) do { unsigned _sp = 0; while (cond) { __builtin_amdgcn_s_sleep(1); \
    if ((++_sp & 255u) == 0u) { if (xb_ld(&(bar)[XB_TMO])) break; if (_sp > XB_SPIN_CAP) { atomicAdd(&(bar)[XB_TMO], 1u); break; } } } } while (0)

struct XcdBarrier {
    unsigned* bar; unsigned x;
    volatile LAS unsigned* st;
};

__device__ __forceinline__ XcdBarrier xcd_barrier_post(unsigned* bar, volatile LAS unsigned* st) {
    XcdBarrier b; b.bar = bar; b.x = xb_xcc_id(); b.st = st;
    if (threadIdx.x == 0) (void)xb_add(&bar[XB_XCNT(b.x)], 1u);
    return b;
}
__device__ __forceinline__ void xcd_barrier_complete(unsigned* bar, unsigned x, unsigned& nloc, unsigned& nx) {
    const unsigned G = gridDim.x * gridDim.y * gridDim.z;
    unsigned sum, cnt, mine, sp = 0u;
    for (;;) {
        sum = 0u; cnt = 0u; mine = 0u;
#pragma unroll
        for (unsigned j = 0; j < 16; ++j) { const unsigned c = xb_ld(&bar[XB_XCNT(j)]); sum += c; cnt += (c > 0u) ? 1u : 0u; mine = (j == x) ? c : mine; }
        if (sum == G) break;
        __builtin_amdgcn_s_sleep(1);
        if ((++sp & 255u) == 0u) { if (xb_ld(&bar[XB_TMO])) break; if (sp > XB_SPIN_CAP) { atomicAdd(&bar[XB_TMO], 1u); break; } }
    }
    nloc = mine > 0u ? mine : 1u; nx = cnt > 0u ? cnt : 1u;
}

__device__ __forceinline__ void xcd_barrier(const XcdBarrier& b) {
    asm volatile("s_waitcnt vmcnt(0)" ::: "memory");
    __syncthreads();
    if (threadIdx.x == 0) {
        unsigned* bar = b.bar;
        __builtin_amdgcn_s_waitcnt(0);
        unsigned nloc = b.st[0], nx = b.st[1];
        if (nloc == 0u) { xcd_barrier_complete(bar, b.x, nloc, nx); b.st[0] = nloc; b.st[1] = nx; }
        const unsigned old = xb_add(&bar[XB_XSUB(b.x)], 1u);
        const unsigned gen = old / nloc;
        if (old + 1u == (gen + 1u) * nloc) {
            __builtin_amdgcn_fence(__ATOMIC_RELEASE, "agent");
            asm volatile("s_waitcnt vmcnt(0)" ::: "memory");
            const unsigned og = xb_add(&bar[XB_TOP], 1u);
            const unsigned tg = og / nx;
            if (og + 1u == (tg + 1u) * nx) xb_add(&bar[XB_TOPGEN], 1u);
            else XB_SPIN(xb_ld(&bar[XB_TOPGEN]) == tg, bar);
            __builtin_amdgcn_fence(__ATOMIC_ACQUIRE, "agent");
            xb_add(&bar[XB_XGEN(b.x)], 1u);
            asm volatile("s_waitcnt vmcnt(0)" ::: "memory");
        } else {
            XB_SPIN(xb_ld(&bar[XB_XGEN(b.x)]) == gen, bar);
            __builtin_amdgcn_fence(__ATOMIC_ACQUIRE, "agent");
            asm volatile("s_waitcnt vmcnt(0)" ::: "memory");
        }
    }
    __syncthreads();
}

constexpr int NPHASE = 8;
__global__ void __launch_bounds__(512, 2) mega_fwd(Params p) {
    extern __shared__ __attribute__((aligned(16))) unsigned char lds[];
    cg::grid_group grid = cg::this_grid();
    const int lo = p.ph_lo, hi = p.ph_hi;
#define IN(k) (lo <= (k) && (k) < hi)
    volatile LAS unsigned* MISC = (volatile LAS unsigned*)((LAS unsigned char*)lds + LDS_BYTES - 64);
    if (threadIdx.x < 2) MISC[threadIdx.x] = 0u;
    __syncthreads();
    const XcdBarrier bar = xcd_barrier_post((unsigned*)(p.ws + WS_BAR), MISC);
    if (hi > NPHASE) grid.sync();
#ifndef SEAM0_CG
#define SEAM0_CG 0
#endif
#define SEAM(k) do { if (IN(k) && IN((k) + 1)) { if (SEAM0_CG && (k) == 0) grid.sync(); else xcd_barrier(bar); } } while (0)
    float* stat = (float*)(p.ws + WS_STAT);
    if (IN(0)) prologue_phase(p, lds);
#if REP_PHASE == 0
    grid.sync(); prologue_phase(p, lds);
#endif
    SEAM(0);
    if (IN(1)) { pg8::Gemm g{(const bf16_t*)(p.ws + WS_XN), (const bf16_t*)(p.ws + WS_W0T), MP, N1, DM}; pg8::StaticOrder S; S.init(MP, N1, gridDim.x, blockIdx.x);
        Epi1 E{(bf16_t*)(p.ws + WS_P1), p.out};
        const bool conv_first = ((blockIdx.x >> 3) & 1) != 0;
        if (conv_first) p0_convert_items(p, (LAS unsigned char*)lds, P0_I0, P0_NIT);
        pg8::gemm_phase<Epi1, pg8::StaticOrder, true, true>((PG8_LAS unsigned char*)lds, g, S, E);
        gemm_small_phase<Epi1>((PG8_LAS unsigned char*)lds, g.A, g.Bt, MP, MS, N1, DM, E);
        if (!conv_first) p0_convert_items(p, (LAS unsigned char*)lds, P0_I0, P0_NIT);
#if REP_PHASE == 1
        grid.sync(); pg8::gemm_phase<Epi1, pg8::StaticOrder, true, true>((PG8_LAS unsigned char*)lds, g, S, E);
#endif
#if REP_PHASE == 11
        grid.sync(); gemm_small_phase<Epi1>((PG8_LAS unsigned char*)lds, g.A, g.Bt, MP, MS, N1, DM, E);
#endif
    }
    SEAM(1);
    if (IN(2)) attn_phase(p, (char*)lds);
#if REP_PHASE == 2
    grid.sync(); attn_phase(p, (char*)lds);
#endif
    SEAM(2);
    if (IN(3)) { pg8::Gemm g{(const bf16_t*)(p.ws + WS_MIX), (const bf16_t*)(p.ws + WS_WO0T), MP, DM, DM}; pg8::StaticOrder S; S.init(MP, DM, gridDim.x, blockIdx.x);
        Epi2 E{p.x_prompt, p.x_sample, p.norm1_g, (float*)(p.ws + WS_H1), (bf16_t*)(p.ws + WS_A1), stat + ST_SSQ1, true}; Epi2 Es = E; Es.pre = false;
        pg8::gemm_phase<Epi2, pg8::StaticOrder, true, true>((PG8_LAS unsigned char*)lds, g, S, E);
        gemm_small_phase<Epi2, 1  >((PG8_LAS unsigned char*)lds, g.A, g.Bt, MP, MS, DM, DM, Es, (float*)(p.ws + WS_SCR), (unsigned*)stat + ST_CNT2); }
    SEAM(3);
    if (IN(4)) { pg8::Gemm g{(const bf16_t*)(p.ws + WS_A1), (const bf16_t*)(p.ws + WS_W1T), MP, N3, DM}; pg8::StaticOrder S; S.init(MP, N3, gridDim.x, blockIdx.x);
        Epi3 E{stat + ST_SSQ1, (bf16_t*)(p.ws + WS_UVZ), stat + ST_VSUM, stat + ST_VSQ};
        pg8::gemm_phase<Epi3, pg8::StaticOrder, true, true>((PG8_LAS unsigned char*)lds, g, S, E);
        gemm_small_phase<Epi3>((PG8_LAS unsigned char*)lds, g.A, g.Bt, MP, MS, N3, DM, E); }
    SEAM(4);
    if (IN(5)) spatial_phase(p, (char*)lds);
#if REP_PHASE == 5
    grid.sync(); spatial_phase(p, (char*)lds);
#endif
    SEAM(5);
    if (IN(6)) { pg8::Gemm g{(const bf16_t*)(p.ws + WS_ACT), (const bf16_t*)(p.ws + WS_WO1T), MP, DM, CW}; pg8::StaticOrder S; S.init(MP, DM, gridDim.x, blockIdx.x);
        Epi4 E{(const float*)(p.ws + WS_H1), p.out, stat + ST_SSQ2, true}; Epi4 Es = E; Es.pre = false;
        pg8::gemm_phase<Epi4, pg8::StaticOrder, true, true>((PG8_LAS unsigned char*)lds, g, S, E);
        gemm_small_phase<Epi4, 1  >((PG8_LAS unsigned char*)lds, g.A, g.Bt, MP, MS, DM, CW, Es, (float*)(p.ws + WS_SCR), (unsigned*)stat + ST_CNT4);
#if REP_PHASE == 64
        { xcd_barrier(bar); Epi4 Ed{(const float*)(p.ws + WS_H1), (float*)(p.ws + WS_UVZ), stat + ST_VSUM, false}; gemm_small_phase<Epi4, 4>((PG8_LAS unsigned char*)lds, g.A, g.Bt, MP, MS, DM, CW, Ed, (float*)(p.ws + WS_SCR), (unsigned*)stat + ST_CNT4 + 200); }
#endif
#if REP_PHASE == 65
        { xcd_barrier(bar); Epi4 Ed{(const float*)(p.ws + WS_H1), (float*)(p.ws + WS_UVZ), stat + ST_VSUM, false}; gemm_small_phase<Epi4, 1>((PG8_LAS unsigned char*)lds, g.A, g.Bt, MP, MS, DM, CW, Ed); }
#endif
    }
    SEAM(6);
#if REP_PHASE == 90
    xcd_barrier(bar); xcd_barrier(bar); xcd_barrier(bar); xcd_barrier(bar); xcd_barrier(bar); xcd_barrier(bar); xcd_barrier(bar); xcd_barrier(bar);
#endif
    if (IN(7)) final_phase(p);
#undef IN
#undef SEAM
}

extern "C" void kernel_launch(void* const* d_in, const int* in_sizes, int n_in, void* d_out, int out_size, void* d_ws, size_t ws_size, hipStream_t stream) {
    static int grid = 0;
    if (grid == 0) {
        if (n_in != 19 || out_size != (int)O_END || ws_size < WS_END) { fprintf(stderr, "kernel_launch: unexpected shapes: n_in %d out %d (want %zu) ws %zu (want %zu)\n", n_in, out_size, (size_t)O_END, ws_size, (size_t)WS_END); grid = -1; return; }
        int dev = 0, cus = 0, per_cu = 0;
        hipGetDevice(&dev); hipDeviceGetAttribute(&cus, hipDeviceAttributeMultiprocessorCount, dev);
        if (hipFuncSetAttribute((const void*)mega_fwd, hipFuncAttributeMaxDynamicSharedMemorySize, LDS_BYTES) != hipSuccess) { fprintf(stderr, "kernel_launch: hipFuncSetAttribute failed\n"); grid = -1; return; }
        if (hipOccupancyMaxActiveBlocksPerMultiprocessor(&per_cu, (const void*)mega_fwd, 512, LDS_BYTES) != hipSuccess || per_cu < 1) { fprintf(stderr, "kernel_launch: occupancy query failed (%d)\n", per_cu); per_cu = 1; }
        (void)hipGetLastError();
        grid = cus * per_cu;
        fprintf(stderr, "kernel_launch: grid %d (%d CUs x %d)\n", grid, cus, per_cu);
    }
    if (grid < 0) return;
    Params p{};
    p.x_prompt = (const float*)d_in[0]; p.x_sample = (const float*)d_in[1]; p.cfk = (const float*)d_in[2]; p.cfv = (const float*)d_in[3]; p.cflogf = (const float*)d_in[4];
    p.csk = (const float*)d_in[5]; p.csv = (const float*)d_in[6]; p.norm0_g = (const float*)d_in[7]; p.w_in0 = (const float*)d_in[8]; p.b_forget = (const float*)d_in[9];
    p.w_out0 = (const float*)d_in[10]; p.norm1_g = (const float*)d_in[11]; p.w_in1 = (const float*)d_in[12]; p.ln_g = (const float*)d_in[13]; p.ln_b = (const float*)d_in[14];
    p.w_sp = (const float*)d_in[15]; p.b_sp = (const float*)d_in[16]; p.w_out1 = (const float*)d_in[17]; p.final_g = (const float*)d_in[18];
    p.out = (float*)d_out; p.ws = (unsigned char*)d_ws;
#if MK_N_LAUNCHES == 1
    p.ph_lo = 0; p.ph_hi = NPHASE;
    if (hipMemsetAsync((char*)d_ws + WS_BAR, 0, XCD_BAR_WORDS * 4, stream) != hipSuccess) { fprintf(stderr, "kernel_launch: hipMemsetAsync of the barrier words failed\n"); return; }
    void* args[] = {&p};
    hipError_t e = hipLaunchCooperativeKernel((const void*)mega_fwd, dim3(grid), dim3(512), args, LDS_BYTES, stream);
    if (e != hipSuccess) fprintf(stderr, "kernel_launch: cooperative launch failed: %s (grid %d)\n", hipGetErrorString(e), grid);
#else
    for (int k = 0; k < NPHASE; ++k) { p.ph_lo = k; p.ph_hi = k + 1; hipLaunchKernelGGL(mega_fwd, dim3(grid), dim3(512), LDS_BYTES, stream, p); }
    hipError_t e = hipPeekAtLastError();
    if (e != hipSuccess) fprintf(stderr, "kernel_launch: launch failed: %s\n", hipGetErrorString(e));
#endif
}
```
